# Optimizing an MI355X kernel written in HIP

```python
import jax, jax.numpy as jnp
from jax import lax
import numpy as np

D_MODEL = 2048
BATCH = 8
SEQ = 2048
DEPTH = 2

HEAD_DIM = 128
MIX_WIDTH = D_MODEL
N_HEADS = MIX_WIDTH // HEAD_DIM
N_HEADS_MOBA = N_HEADS // 4
N_HEADS_DIL = (N_HEADS - N_HEADS_MOBA) // 2
N_HEADS_FOX = N_HEADS - N_HEADS_MOBA - N_HEADS_DIL
DILATED_BRANCHES = ((128, 1), (512, 4), (2048, 16))
BAND_BLOCK = 128
MOBA_BLOCK = 256
MOBA_TOPK = 3
Q_BLOCK = 128
ROPE_THETA = 500000.0
ROT_DIM = HEAD_DIM // 4
D_FF = (7 * D_MODEL) // 2
N_EXPERTS = 8
TOP_K = 2
N_DENSE = (DEPTH + 1) // 2
N_MOE = DEPTH // 2
N_MOD = 6
RMS_EPS = 1e-6
NEG_INF = -1e30
FORGET_BIAS = 2.0
ATTN_SCALE = HEAD_DIM ** -0.5

kernel_name = 'hybrid_dilated_moba_fox_moe_block'


def rms_norm(x, g):
    xf = x.astype(jnp.float32)
    y = xf * lax.rsqrt(jnp.mean(xf * xf, axis=-1, keepdims=True) + RMS_EPS)
    return (y * g.astype(jnp.float32)).astype(x.dtype)


def modulate(h, shift, scale):
    return h * (1 + scale[:, None, :]) + shift[:, None, :]


def partial_rotary(t, positions):
    half = ROT_DIM // 2
    inv_freq = ROPE_THETA ** (-jnp.arange(half, dtype=jnp.float32) / half)
    ang = positions.astype(jnp.float32)[:, None, :, None] * inv_freq
    cos, sin = jnp.cos(ang), jnp.sin(ang)
    tr = t[..., :ROT_DIM].astype(jnp.float32)
    t1, t2 = tr[..., :half], tr[..., half:]
    rot = jnp.concatenate([t1 * cos - t2 * sin, t2 * cos + t1 * sin], axis=-1)
    return jnp.concatenate([rot.astype(t.dtype), t[..., ROT_DIM:]], axis=-1)


def dilated_branch(q, k, v, window, dilation):
    bsz, nh, seq, hd = q.shape
    sub_len = seq // dilation
    band = window // dilation
    n_b = -(-sub_len // BAND_BLOCK)
    pad_len = n_b * BAND_BLOCK - sub_len

    def to_sub(t):
        t = t.astype(jnp.float32).reshape(bsz, nh, sub_len, dilation, hd).transpose(0, 1, 3, 2, 4)
        t = jnp.pad(t, ((0, 0), (0, 0), (0, 0), (0, pad_len), (0, 0)))
        return t.reshape(bsz, nh, dilation, n_b, BAND_BLOCK, hd)

    def with_prev(t):
        prev = jnp.pad(t, ((0, 0), (0, 0), (0, 0), (1, 0), (0, 0), (0, 0)))[:, :, :, :-1]
        return jnp.concatenate([prev, t], axis=4)

    qs = to_sub(q) * ATTN_SCALE
    kb = with_prev(to_sub(k))
    vb = with_prev(to_sub(v))
    blk = jnp.arange(n_b)[:, None, None] * BAND_BLOCK
    q_idx = blk + jnp.arange(BAND_BLOCK)[None, :, None]
    k_idx = blk - BAND_BLOCK + jnp.arange(2 * BAND_BLOCK)[None, None, :]
    dist = q_idx - k_idx
    valid = (dist >= 0) & (dist <= band) & (k_idx >= 0)
    logits = jnp.where(valid, jnp.einsum('bhrnqd,bhrnkd->bhrnqk', qs, kb), NEG_INF)
    m = jnp.max(logits, axis=-1, keepdims=True)
    p = jnp.exp(logits - m)
    den = jnp.sum(p, axis=-1)
    o = jnp.einsum('bhrnqk,bhrnkd->bhrnqd', p, vb) / den[..., None]
    lse = m[..., 0] + jnp.log(den)
    o = o.reshape(bsz, nh, dilation, n_b * BAND_BLOCK, hd)[:, :, :, :sub_len]
    o = o.transpose(0, 1, 3, 2, 4).reshape(bsz, nh, seq, hd)
    lse = lse.reshape(bsz, nh, dilation, n_b * BAND_BLOCK)[..., :sub_len]
    lse = lse.transpose(0, 1, 3, 2).reshape(bsz, nh, seq)
    return o, lse


def dilated_attention(q, k, v):
    outs, lses = [], []
    for window, dilation in DILATED_BRANCHES:
        o, lse = dilated_branch(q, k, v, window, dilation)
        outs.append(o)
        lses.append(lse)
    wts = jax.nn.softmax(jnp.stack(lses, axis=0), axis=0)
    return jnp.einsum('nbhs,nbhsd->bhsd', wts, jnp.stack(outs, axis=0))


def moba_attention(q, k, v):
    bsz, nh, seq, hd = q.shape
    n_kb = -(-seq // MOBA_BLOCK)
    pad = ((0, 0), (0, 0), (0, n_kb * MOBA_BLOCK - seq), (0, 0))
    kb = jnp.pad(k, pad).reshape(bsz, nh, n_kb, MOBA_BLOCK, hd).astype(jnp.float32)
    vb = jnp.pad(v, pad).reshape(bsz, nh, n_kb, MOBA_BLOCK, hd).astype(jnp.float32)
    cur = jnp.arange(seq) // MOBA_BLOCK
    n_sel = min(MOBA_TOPK, n_kb - 1)
    if n_sel > 0:
        k_mean = kb.mean(axis=3)
        gate = jnp.einsum('bhsd,bhnd->bhsn', q.astype(jnp.float32), k_mean)
        fully_past = jnp.arange(n_kb)[None, :] < cur[:, None]
        gate = jnp.where(fully_past, gate, NEG_INF)
        _, sel = lax.top_k(gate, n_sel)
    else:
        sel = jnp.zeros((bsz, nh, seq, 0), jnp.int32)
    sel_valid = jnp.arange(n_sel)[None, :] < cur[:, None]
    n_qb = seq // Q_BLOCK
    qc = (q.astype(jnp.float32) * ATTN_SCALE).reshape(bsz, nh, n_qb, Q_BLOCK, hd).transpose(2, 0, 1, 3, 4)
    selc = sel.reshape(bsz, nh, n_qb, Q_BLOCK, n_sel).transpose(2, 0, 1, 3, 4)
    validc = sel_valid.reshape(n_qb, Q_BLOCK, n_sel)
    b_idx = jnp.arange(bsz)[:, None, None]
    h_idx = jnp.arange(nh)[None, :, None]

    def block_attend(args):
        i, q_blk, sel_blk, valid_blk = args
        start = i * Q_BLOCK
        own = start // MOBA_BLOCK
        k_own = lax.dynamic_index_in_dim(kb, own, axis=2, keepdims=False)
        v_own = lax.dynamic_index_in_dim(vb, own, axis=2, keepdims=False)
        q_pos = start + jnp.arange(Q_BLOCK)
        k_pos = own * MOBA_BLOCK + jnp.arange(MOBA_BLOCK)
        logits = [jnp.where(k_pos[None, :] <= q_pos[:, None],
                            jnp.einsum('bhqd,bhkd->bhqk', q_blk, k_own), NEG_INF)]
        for r in range(n_sel):
            k_sel = kb[b_idx, h_idx, sel_blk[..., r]]
            l_sel = jnp.einsum('bhqd,bhqkd->bhqk', q_blk, k_sel)
            logits.append(jnp.where(valid_blk[None, None, :, r, None], l_sel, NEG_INF))
        p = jax.nn.softmax(jnp.concatenate(logits, axis=-1), axis=-1)
        out = jnp.einsum('bhqk,bhkd->bhqd', p[..., :MOBA_BLOCK], v_own)
        for r in range(n_sel):
            v_sel = vb[b_idx, h_idx, sel_blk[..., r]]
            out = out + jnp.einsum('bhqk,bhqkd->bhqd',
                                   p[..., (r + 1) * MOBA_BLOCK:(r + 2) * MOBA_BLOCK], v_sel)
        return out

    out = lax.map(block_attend, (jnp.arange(n_qb), qc, selc, validc))
    return out.transpose(1, 2, 0, 3, 4).reshape(bsz, nh, seq, hd)


def forgetting_attention(q, k, v, log_f):
    bsz, nh, seq, hd = q.shape
    cum_f = lax.cumsum(log_f, axis=2)
    kf = k.astype(jnp.float32)
    vf = v.astype(jnp.float32)
    n_qb = seq // Q_BLOCK
    qc = (q.astype(jnp.float32) * ATTN_SCALE).reshape(bsz, nh, n_qb, Q_BLOCK, hd).transpose(2, 0, 1, 3, 4)
    fc = cum_f.reshape(bsz, nh, n_qb, Q_BLOCK).transpose(2, 0, 1, 3)
    k_pos = jnp.arange(seq)

    def block_attend(args):
        i, q_blk, f_blk = args
        q_pos = i * Q_BLOCK + jnp.arange(Q_BLOCK)
        logits = jnp.einsum('bhqd,bhkd->bhqk', q_blk, kf) + f_blk[..., None] - cum_f[:, :, None, :]
        logits = jnp.where(k_pos[None, :] <= q_pos[:, None], logits, NEG_INF)
        p = jax.nn.softmax(logits, axis=-1)
        return jnp.einsum('bhqk,bhkd->bhqd', p, vf)

    out = lax.map(block_attend, (jnp.arange(n_qb), qc, fc))
    return out.transpose(1, 2, 0, 3, 4).reshape(bsz, nh, seq, hd)


def token_mixer(h, positions, w_in, b_fgate, w_out):
    bsz, seq, _ = h.shape
    proj = h @ w_in
    qkv = proj[..., :3 * MIX_WIDTH].reshape(bsz, seq, 3, N_HEADS, HEAD_DIM).transpose(2, 0, 3, 1, 4)
    q, k, v = qkv[0], qkv[1], qkv[2]
    log_f = jax.nn.log_sigmoid((proj[..., 3 * MIX_WIDTH:] + b_fgate).astype(jnp.float32)).transpose(0, 2, 1)
    n_rot = N_HEADS_DIL + N_HEADS_MOBA
    q_rot = partial_rotary(q[:, :n_rot], positions)
    k_rot = partial_rotary(k[:, :n_rot], positions)
    o_dil = dilated_attention(q_rot[:, :N_HEADS_DIL], k_rot[:, :N_HEADS_DIL], v[:, :N_HEADS_DIL])
    o_moba = moba_attention(q_rot[:, N_HEADS_DIL:], k_rot[:, N_HEADS_DIL:], v[:, N_HEADS_DIL:n_rot])
    o_fox = forgetting_attention(q[:, n_rot:], k[:, n_rot:], v[:, n_rot:], log_f)
    o = jnp.concatenate([o_dil, o_moba, o_fox], axis=1).astype(h.dtype)
    o = o.transpose(0, 2, 1, 3).reshape(bsz, seq, MIX_WIDTH)
    return o @ w_out


def swiglu(h, w_gate, w_up, w_down):
    return (jax.nn.silu(h @ w_gate) * (h @ w_up)) @ w_down


def moe_swiglu(h, w_router, b_router, w_gate, w_up, w_down):
    logits = (h @ w_router).astype(jnp.float32) + b_router.astype(jnp.float32)
    top_val, top_idx = lax.top_k(logits, TOP_K)
    top_p = jax.nn.softmax(top_val, axis=-1)
    gates = jnp.einsum('bske,bsk->bse', jax.nn.one_hot(top_idx, N_EXPERTS, dtype=jnp.float32), top_p)
    out = jnp.zeros(h.shape, jnp.float32)
    for e in range(N_EXPERTS):
        out = out + gates[..., e:e + 1] * swiglu(h, w_gate[e], w_up[e], w_down[e])
    return out.astype(h.dtype)


def setup_inputs(seed: int = 0) -> dict:
    key = jax.random.key(seed)
    ks = jax.random.split(key, 20)
    f32 = jnp.float32

    def nrm(k, shape, fan_in, mult=1.0):
        return jax.random.normal(k, shape, f32) * (mult * fan_in ** -0.5)

    def gain(k, shape):
        return 1.0 + 0.05 * jax.random.normal(k, shape, f32)

    n_in = 3 * MIX_WIDTH + N_HEADS_FOX
    positions = (jnp.arange(SEQ, dtype=jnp.int32)[None, :]
                 + jax.random.randint(ks[2], (BATCH, 1), 0, 4096, dtype=jnp.int32))
    return {
        'x': jax.random.normal(ks[0], (BATCH, SEQ, D_MODEL), f32),
        'c': jax.random.normal(ks[1], (BATCH, D_MODEL), f32),
        'positions': positions,
        'ln_mix_pre': gain(ks[3], (DEPTH, D_MODEL)),
        'ln_mix_post': gain(ks[4], (DEPTH, D_MODEL)),
        'ln_ffn_pre': gain(ks[5], (DEPTH, D_MODEL)),
        'ln_ffn_post': gain(ks[6], (DEPTH, D_MODEL)),
        'w_mod': nrm(ks[7], (DEPTH, D_MODEL, N_MOD * D_MODEL), D_MODEL, 0.5),
        'b_mod': 0.02 * jax.random.normal(ks[8], (DEPTH, N_MOD * D_MODEL), f32),
        'w_in': nrm(ks[9], (DEPTH, D_MODEL, n_in), D_MODEL),
        'b_fgate': FORGET_BIAS + 0.5 * jax.random.normal(ks[10], (DEPTH, N_HEADS_FOX), f32),
        'w_out': nrm(ks[11], (DEPTH, MIX_WIDTH, D_MODEL), MIX_WIDTH),
        'w_ffn_gate': nrm(ks[12], (N_DENSE, D_MODEL, D_FF), D_MODEL),
        'w_ffn_up': nrm(ks[13], (N_DENSE, D_MODEL, D_FF), D_MODEL),
        'w_ffn_down': nrm(ks[14], (N_DENSE, D_FF, D_MODEL), D_FF),
        'w_router': nrm(ks[15], (N_MOE, D_MODEL, N_EXPERTS), D_MODEL),
        'b_router': 0.01 * jax.random.normal(ks[16], (N_MOE, N_EXPERTS), f32),
        'w_exp_gate': nrm(ks[17], (N_MOE, N_EXPERTS, D_MODEL, D_FF), D_MODEL),
        'w_exp_up': nrm(ks[18], (N_MOE, N_EXPERTS, D_MODEL, D_FF), D_MODEL),
        'w_exp_down': nrm(ks[19], (N_MOE, N_EXPERTS, D_FF, D_MODEL), D_FF),
    }


def reference(x, c, positions, ln_mix_pre, ln_mix_post, ln_ffn_pre, ln_ffn_post, w_mod, b_mod,
              w_in, b_fgate, w_out, w_ffn_gate, w_ffn_up, w_ffn_down, w_router, b_router,
              w_exp_gate, w_exp_up, w_exp_down):
    cond = jax.nn.silu(c)
    for layer in range(DEPTH):
        mod = cond @ w_mod[layer] + b_mod[layer]
        sh_m, sc_m, g_m, sh_f, sc_f, g_f = jnp.split(mod, N_MOD, axis=-1)
        h = modulate(rms_norm(x, ln_mix_pre[layer]), sh_m, sc_m)
        y = token_mixer(h, positions, w_in[layer], b_fgate[layer], w_out[layer])
        x = x + g_m[:, None, :] * rms_norm(y, ln_mix_post[layer])
        h = modulate(rms_norm(x, ln_ffn_pre[layer]), sh_f, sc_f)
        j = layer // 2
        if layer % 2 == 0:
            y = swiglu(h, w_ffn_gate[j], w_ffn_up[j], w_ffn_down[j])
        else:
            y = moe_swiglu(h, w_router[j], b_router[j], w_exp_gate[j], w_exp_up[j], w_exp_down[j])
        x = x + g_f[:, None, :] * rms_norm(y, ln_ffn_post[layer])
    return x
```

```cpp
#include <hip/hip_runtime.h>
#include <cstdio>
#include <cstdint>

#ifndef DENSE_F8
#define DENSE_F8 3
#endif
#ifndef X_BF16
#define X_BF16 1
#endif
#ifndef MK_N_LAUNCHES
#define MK_N_LAUNCHES 1
#endif

namespace pg8 {
#define PG8_LAS __attribute__((address_space(3)))
typedef unsigned short bf16_t;
typedef short bf16x8 __attribute__((ext_vector_type(8)));
typedef float f32x4 __attribute__((ext_vector_type(4)));
typedef unsigned u32x4 __attribute__((ext_vector_type(4)));
typedef int i32x4 __attribute__((ext_vector_type(4)));
typedef int i32x8 __attribute__((ext_vector_type(8)));
constexpr int BM = 256, BK = 64, HALF = 128, HTB = HALF * BK * 2  , STAGE_BYTES = 8 * HTB, NXCD = 8, WGM = 8;

__host__ __device__ __forceinline__ int lds_byte(int r, int c) { const int st = (r >> 4) * 2 + (c >> 5), rr = r & 15, cc = c & 31, ob = rr * 64 + cc * 2; return st * 1024 + (ob ^ (((ob >> 9) & 1) << 5)); }
__host__ __device__ __forceinline__ void stage_rc(int b, int& R, int& C) { const int st = b / 1024, sb = b % 1024, swz = sb ^ (((sb >> 9) & 1) << 5); R = (st >> 1) * 16 + swz / 64; C = (st & 1) * 32 + (swz % 64) / 2; }
__host__ __device__ __forceinline__ int perm32(int rho) { const int n = rho >> 4, i = rho & 15; return 8 * (i >> 2) + 4 * n + (i & 3); }

struct Unit { int pm, pn; };

struct GSched {
    int nM, nN, nwg, G, c; const char* A; const char* Bt; size_t tstepA, tstepB, estep; int ts1, ts2, ts3, ts4, ts5, ts6, ts7;
    __device__ __forceinline__ void init(int nM_, int nN_, int K, int G_, int c_, const void* A_, const void* Bt_, size_t estep_) {
        nM = nM_; nN = nN_; nwg = nM * nN; G = G_; c = c_; A = (const char*)A_; Bt = (const char*)Bt_; tstepA = (size_t)BM * K * 2; tstepB = tstepA; estep = estep_;
        ts1 = ts2 = ts3 = ts4 = ts5 = ts6 = ts7 = 0x7fffffff; }
    __device__ __forceinline__ bool next(int i, Unit& u) const {
        const long L = (long)i * G + c; if (L >= nwg) return false;
        int wgid = (int)L; { const int q = nwg / NXCD, r = nwg % NXCD, xcd = wgid % NXCD, off = wgid / NXCD; wgid = (xcd < r ? xcd * (q + 1) : r * (q + 1) + (xcd - r) * q) + off; }
        const int nig = WGM * nN, gid = wgid / nig, fm = gid * WGM, gsz = (nM - fm) < WGM ? (nM - fm) : WGM;
        u.pm = fm + ((wgid % nig) % gsz); u.pn = (wgid % nig) / gsz; return true;
    }
    __device__ __forceinline__ const char* aptr(const Unit& u) const { return A + (size_t)u.pm * tstepA; }
    __device__ __forceinline__ const char* bptr(const Unit& u) const {
        const int e = (u.pm >= ts1) + (u.pm >= ts2) + (u.pm >= ts3) + (u.pm >= ts4) + (u.pm >= ts5) + (u.pm >= ts6) + (u.pm >= ts7);
        return Bt + (size_t)e * estep + (size_t)u.pn * tstepB; }
    __device__ __forceinline__ void a_ready(const Unit&) const {}
    __device__ __forceinline__ void done(const Unit&) const {}
};

struct GSchedK : GSched {
    int pm0; size_t kbytes;
    __device__ __forceinline__ const char* aptr(const Unit& u) const { return A + (size_t)(pm0 + u.pm) * tstepA + (size_t)(u.pn >> 3) * kbytes; }
    __device__ __forceinline__ const char* bptr(const Unit& u) const { const int t = pm0 + u.pm;
        const int e = (t >= ts1) + (t >= ts2) + (t >= ts3) + (t >= ts4) + (t >= ts5) + (t >= ts6) + (t >= ts7);
        return Bt + (size_t)e * estep + (size_t)(u.pn & 7) * tstepB + (size_t)(u.pn >> 3) * kbytes; }
};
__device__ __forceinline__ unsigned cvt_pk_bf16(float lo, float hi) { unsigned r; asm volatile("v_cvt_pk_bf16_f32 %0, %1, %2" : "=v"(r) : "v"(lo), "v"(hi)); return r; }
typedef unsigned u32x2 __attribute__((ext_vector_type(2)));

struct EpiBf16 {
    static constexpr bool PERM = true, AFTER_DRAIN = false;
    bf16_t* O; int ldc; float scale;
    __device__ __forceinline__ void operator()(const f32x4 (&acc)[2][2][4][2], const Unit& u, int wr, int wc, int fr, int fq) const {
        const int row0 = u.pm * BM + wr * 64 + fr, col0 = u.pn * BM + wc * 32 + 8 * fq;
#pragma unroll
        for (int ai = 0; ai < 2; ++ai)
#pragma unroll
            for (int m = 0; m < 4; ++m) { bf16_t* rowp = O + (size_t)(row0 + ai * HALF + m * 16) * ldc + col0;
#pragma unroll
                for (int bj = 0; bj < 2; ++bj) { const f32x4 v0 = acc[ai][bj][m][0] * scale, v1 = acc[ai][bj][m][1] * scale;
                    u32x4 w; w.x = cvt_pk_bf16(v0[0], v0[1]); w.y = cvt_pk_bf16(v0[2], v0[3]); w.z = cvt_pk_bf16(v1[0], v1[1]); w.w = cvt_pk_bf16(v1[2], v1[3]);
                    *(u32x4*)(rowp + bj * HALF) = w; } }
    }
};
struct EpiBf16K {
    static constexpr bool PERM = true, AFTER_DRAIN = false;
    bf16_t* O; int ldc; float scale; size_t pstride;
    __device__ __forceinline__ void operator()(const f32x4 (&acc)[2][2][4][2], const Unit& u, int wr, int wc, int fr, int fq) const {
        const int row0 = u.pm * BM + wr * 64 + fr, col0 = (u.pn & 7) * BM + wc * 32 + 8 * fq; bf16_t* Ob = O + (size_t)(u.pn >> 3) * pstride;
#pragma unroll
        for (int ai = 0; ai < 2; ++ai)
#pragma unroll
            for (int m = 0; m < 4; ++m) { bf16_t* rowp = Ob + (size_t)(row0 + ai * HALF + m * 16) * ldc + col0;
#pragma unroll
                for (int bj = 0; bj < 2; ++bj) { const f32x4 v0 = acc[ai][bj][m][0] * scale, v1 = acc[ai][bj][m][1] * scale;
                    u32x4 w; w.x = cvt_pk_bf16(v0[0], v0[1]); w.y = cvt_pk_bf16(v0[2], v0[3]); w.z = cvt_pk_bf16(v1[0], v1[1]); w.w = cvt_pk_bf16(v1[2], v1[3]);
                    *(u32x4*)(rowp + bj * HALF) = w; } }
    }
};
__device__ __forceinline__ float silu_mul(float g, float u) { return g * u * __builtin_amdgcn_rcpf(1.0f + __builtin_amdgcn_exp2f(-1.4426950408889634f * g)); }
struct EpiSwiGLU {
    static constexpr bool PERM = true, AFTER_DRAIN = false;
    bf16_t* O; int ldc; float scale;
    __device__ __forceinline__ void operator()(const f32x4 (&acc)[2][2][4][2], const Unit& u, int wr, int wc, int fr, int fq) const {
        const int row0 = u.pm * BM + wr * 64 + fr, col0 = u.pn * HALF + wc * 32 + 8 * fq;
#pragma unroll
        for (int ai = 0; ai < 2; ++ai)
#pragma unroll
            for (int m = 0; m < 4; ++m) { bf16_t* rowp = O + (size_t)(row0 + ai * HALF + m * 16) * ldc + col0;
                const f32x4 g0 = acc[ai][0][m][0] * scale, g1 = acc[ai][0][m][1] * scale, u0 = acc[ai][1][m][0] * scale, u1 = acc[ai][1][m][1] * scale;
                u32x4 w; w.x = cvt_pk_bf16(silu_mul(g0[0], u0[0]), silu_mul(g0[1], u0[1])); w.y = cvt_pk_bf16(silu_mul(g0[2], u0[2]), silu_mul(g0[3], u0[3]));
                w.z = cvt_pk_bf16(silu_mul(g1[0], u1[0]), silu_mul(g1[1], u1[1])); w.w = cvt_pk_bf16(silu_mul(g1[2], u1[2]), silu_mul(g1[3], u1[3]));
                *(u32x4*)rowp = w; }
    }
};
__device__ __forceinline__ unsigned pk4_fp8(float a, float b, float c, float d) { unsigned w = 0u; w = __builtin_amdgcn_cvt_pk_fp8_f32(a, b, w, false); w = __builtin_amdgcn_cvt_pk_fp8_f32(c, d, w, true); return w; }
struct EpiSwiGLU8 {
    static constexpr bool PERM = true, AFTER_DRAIN = false;
    unsigned char* O; int ldc; float scale;
    __device__ __forceinline__ void operator()(const f32x4 (&acc)[2][2][4][2], const Unit& u, int wr, int wc, int fr, int fq) const {
        const int row0 = u.pm * BM + wr * 64 + fr, col0 = u.pn * HALF + wc * 32 + 8 * fq;
#pragma unroll
        for (int ai = 0; ai < 2; ++ai)
#pragma unroll
            for (int m = 0; m < 4; ++m) { unsigned char* rowp = O + (size_t)(row0 + ai * HALF + m * 16) * ldc + col0;
                const f32x4 g0 = acc[ai][0][m][0] * scale, g1 = acc[ai][0][m][1] * scale, u0 = acc[ai][1][m][0] * scale, u1 = acc[ai][1][m][1] * scale;
                u32x2 w; w.x = pk4_fp8(silu_mul(g0[0], u0[0]), silu_mul(g0[1], u0[1]), silu_mul(g0[2], u0[2]), silu_mul(g0[3], u0[3]));
                w.y = pk4_fp8(silu_mul(g1[0], u1[0]), silu_mul(g1[1], u1[1]), silu_mul(g1[2], u1[2]), silu_mul(g1[3], u1[3]));
                *(u32x2*)rowp = w; }
    }
};
struct EpiQKV {
    static constexpr bool PERM = true, AFTER_DRAIN = false;
    bf16_t* QKV; size_t tstride; const float* rope; float* km; float qscale;
    __device__ __forceinline__ void operator()(const f32x4 (&acc)[2][2][4][2], const Unit& u, int wr, int wc, int fr, int fq) const {
        const int which = u.pn >> 3, b = u.pm >> 3, blk = u.pm & 7, s0 = blk * 256, head0 = 2 * (u.pn & 7);
        bf16_t* base = QKV + (size_t)which * tstride;
        const float sc = which == 0 ? qscale : 1.0f;
        const bool rot = (which < 2) && (head0 < 10) && (wc == 0);
        const bool dokm = (which == 1) && (head0 >= 6) && (head0 < 10);
        const bool hi = fq >= 2;
        bf16_t* hb = base + ((size_t)(b * 16 + head0) * 2048 + s0) * 128 + wc * 32 + 8 * fq;
        f32x4 ks[2][2] = {{{0.f, 0.f, 0.f, 0.f}, {0.f, 0.f, 0.f, 0.f}}, {{0.f, 0.f, 0.f, 0.f}, {0.f, 0.f, 0.f, 0.f}}};
        const float* rp0 = rope + (size_t)(b * 2048 + s0 + wr * 64 + fr) * 32 + 8 * (fq & 1);
        f32x4 cn0 = {1.f, 1.f, 1.f, 1.f}, cn1 = cn0, sn0 = {0.f, 0.f, 0.f, 0.f}, sn1 = sn0;
        if (rot) { cn0 = *(const f32x4*)rp0; cn1 = *(const f32x4*)(rp0 + 4); sn0 = *(const f32x4*)(rp0 + 16); sn1 = *(const f32x4*)(rp0 + 20); }
#pragma unroll
        for (int g = 0; g < 8; ++g) { const int ai = g >> 2, m = g & 3, row = ai * HALF + wr * 64 + m * 16 + fr;
            const f32x4 c0 = cn0, c1 = cn1; f32x4 q0 = sn0, q1 = sn1;
            if (rot && g < 7) { const int gn = g + 1; const float* rp = rp0 + (size_t)((gn >> 2) * HALF + (gn & 3) * 16) * 32; cn0 = *(const f32x4*)rp; cn1 = *(const f32x4*)(rp + 4); sn0 = *(const f32x4*)(rp + 16); sn1 = *(const f32x4*)(rp + 20); }
            if (rot) { q0 = hi ? q0 : -q0; q1 = hi ? q1 : -q1; }
#pragma unroll
            for (int bj = 0; bj < 2; ++bj) {
                f32x4 v0 = acc[ai][bj][m][0], v1 = acc[ai][bj][m][1];
                if (rot) {
#pragma unroll
                    for (int k = 0; k < 4; ++k) {
                        { const auto r = __builtin_amdgcn_permlane32_swap(__float_as_uint(v0[k]), __float_as_uint(v0[k]), false, false);
                          const float other = hi ? __uint_as_float(r[0]) : __uint_as_float(r[1]); v0[k] = v0[k] * c0[k] + other * q0[k]; }
                        { const auto r = __builtin_amdgcn_permlane32_swap(__float_as_uint(v1[k]), __float_as_uint(v1[k]), false, false);
                          const float other = hi ? __uint_as_float(r[0]) : __uint_as_float(r[1]); v1[k] = v1[k] * c1[k] + other * q1[k]; } } }
                v0 = v0 * sc; v1 = v1 * sc;
                if (dokm) { ks[bj][0] += v0; ks[bj][1] += v1; }
                u32x4 w; w.x = cvt_pk_bf16(v0[0], v0[1]); w.y = cvt_pk_bf16(v0[2], v0[3]); w.z = cvt_pk_bf16(v1[0], v1[1]); w.w = cvt_pk_bf16(v1[2], v1[3]);
                *(u32x4*)(hb + (size_t)bj * 2048 * 128 + (size_t)row * 128) = w; }
            asm volatile("" ::: "memory");
        }
        if (dokm) {
#define PG8_SX(v, X) __builtin_bit_cast(float, __builtin_amdgcn_ds_swizzle(__builtin_bit_cast(int, (float)(v)), (((X) << 10) | 0x1F)))
#define PG8_RED16(v) do { v += PG8_SX(v, 1); v += PG8_SX(v, 2); v += PG8_SX(v, 4); v += PG8_SX(v, 8); } while (0)
#pragma unroll
            for (int bj = 0; bj < 2; ++bj) {
                float a0 = ks[bj][0][0], a1 = ks[bj][0][1], a2 = ks[bj][0][2], a3 = ks[bj][0][3], c0 = ks[bj][1][0], c1 = ks[bj][1][1], c2 = ks[bj][1][2], c3 = ks[bj][1][3];
                PG8_RED16(a0); PG8_RED16(a1); PG8_RED16(a2); PG8_RED16(a3); PG8_RED16(c0); PG8_RED16(c1); PG8_RED16(c2); PG8_RED16(c3);
                if (fr == 0) { float* kp = km + ((size_t)((b * 4 + (head0 + bj - 6)) * 8 + blk)) * 128 + wc * 32 + 8 * fq;
                    __hip_atomic_fetch_add(kp + 0, a0, __ATOMIC_RELAXED, __HIP_MEMORY_SCOPE_AGENT); __hip_atomic_fetch_add(kp + 1, a1, __ATOMIC_RELAXED, __HIP_MEMORY_SCOPE_AGENT);
                    __hip_atomic_fetch_add(kp + 2, a2, __ATOMIC_RELAXED, __HIP_MEMORY_SCOPE_AGENT); __hip_atomic_fetch_add(kp + 3, a3, __ATOMIC_RELAXED, __HIP_MEMORY_SCOPE_AGENT);
                    __hip_atomic_fetch_add(kp + 4, c0, __ATOMIC_RELAXED, __HIP_MEMORY_SCOPE_AGENT); __hip_atomic_fetch_add(kp + 5, c1, __ATOMIC_RELAXED, __HIP_MEMORY_SCOPE_AGENT);
                    __hip_atomic_fetch_add(kp + 6, c2, __ATOMIC_RELAXED, __HIP_MEMORY_SCOPE_AGENT); __hip_atomic_fetch_add(kp + 7, c3, __ATOMIC_RELAXED, __HIP_MEMORY_SCOPE_AGENT); } }
#undef PG8_RED16
#undef PG8_SX
        }
    }
};

template <class Epi, class Sched, bool ALIGN_EPI = false, bool SP2 = false, bool F8 = false>
__device__ __forceinline__ void gemm_phase(PG8_LAS unsigned char* lds, const int K, const Sched& S, const Epi& E, const int ntiles = 0) {
    int tid_ = threadIdx.x; asm volatile("" : "+v"(tid_));
    const int tid = tid_, wid = __builtin_amdgcn_readfirstlane(tid >> 6), lane = tid & 63, wr = wid >> 2, wc = wid & 3, fr = lane & 15, fq = lane >> 4;
    const int nt = ntiles ? ntiles : K / BK;
    unsigned voffA[2], voffB[2];
#pragma unroll
    for (int i = 0; i < 2; ++i) { int R, C; stage_rc(tid * 16 + i * 8192, R, C); const int Rb = Epi::PERM ? ((R & ~31) + perm32(R & 31)) : R;
        voffA[i] = (unsigned)(R * K + C) * 2u; voffB[i] = (unsigned)(Rb * K + C) * 2u; }
    const size_t kstep = (size_t)(BK * 2);
    const size_t hstep = (size_t)HALF * K * 2;
    const unsigned ldsw = (unsigned)wid * 1024u;
    const int aoff = lds_byte(wr * 64 + fr, fq * 8), boff = lds_byte(wc * 32 + fr, fq * 8);
    PG8_LAS unsigned char* const ldsB = lds + 4 * HTB + boff;
#define PG8_SA(b, h) (((b) * 2 + (h)) * HTB)
#define PG8_SB(b, h) ((4 + (b) * 2 + (h)) * HTB)
#define PG8_STAGE(bufoff, gbase, voff) do { _Pragma("unroll") for (int _i = 0; _i < 2; ++_i) \
        __builtin_amdgcn_global_load_lds((const unsigned*)((const char*)(gbase) + (voff)[_i]), (PG8_LAS unsigned*)(lds + (bufoff) + ldsw + _i * 8192), 16, 0, 0); } while (0)
#define PG8_LD8(off) __builtin_shufflevector(*(const PG8_LAS i32x4*)(lds + (off)), *(const PG8_LAS i32x4*)(lds + (off) + 1024), 0, 1, 2, 3, 4, 5, 6, 7)
#define PG8_LDA(dst, b, h) do { if constexpr (F8) { _Pragma("unroll") for (int m = 0; m < 4; ++m) dst##8[m] = PG8_LD8(PG8_SA(b, h) + aoff + m * 2048); } \
        else { _Pragma("unroll") for (int m = 0; m < 4; ++m) _Pragma("unroll") for (int k = 0; k < 2; ++k) dst[m][k] = *(const PG8_LAS bf16x8*)(lds + PG8_SA(b, h) + aoff + m * 2048 + k * 1024); } } while (0)
#define PG8_LDB(dst, b, h) do { if constexpr (F8) { _Pragma("unroll") for (int n = 0; n < 2; ++n) dst##8[n] = __builtin_shufflevector(*(const PG8_LAS i32x4*)(ldsB + ((b) * 2 + (h)) * HTB + n * 2048), *(const PG8_LAS i32x4*)(ldsB + ((b) * 2 + (h)) * HTB + n * 2048 + 1024), 0, 1, 2, 3, 4, 5, 6, 7); } \
        else { _Pragma("unroll") for (int n = 0; n < 2; ++n) _Pragma("unroll") for (int k = 0; k < 2; ++k) dst[n][k] = *(const PG8_LAS bf16x8*)(lds + PG8_SB(b, h) + boff + n * 2048 + k * 1024); } } while (0)
#define PG8_MMA(ai, bj, At, Bt) do { __builtin_amdgcn_s_setprio(1); \
        if constexpr (F8) { _Pragma("unroll") for (int m = 0; m < 4; ++m) _Pragma("unroll") for (int n = 0; n < 2; ++n) \
            asm volatile("v_mfma_scale_f32_16x16x128_f8f6f4 %0, %1, %2, %0, %3, %3 op_sel_hi:[0,0,0]" : "+v"(acc[ai][bj][m][n]) : "v"(Bt##8[n]), "v"(At##8[m]), "v"(one8)); } \
        else { _Pragma("unroll") for (int m = 0; m < 4; ++m) _Pragma("unroll") for (int n = 0; n < 2; ++n) _Pragma("unroll") for (int k = 0; k < 2; ++k) \
            acc[ai][bj][m][n] = __builtin_amdgcn_mfma_f32_16x16x32_bf16(Bt[n][k], At[m][k], acc[ai][bj][m][n], 0, 0, 0); } \
        __builtin_amdgcn_s_setprio(0); } while (0)
#define PG8_WAIT_V(n) asm volatile("s_waitcnt vmcnt(" #n ")" ::: "memory")
#define PG8_WAIT_L(n) asm volatile("s_waitcnt lgkmcnt(" #n ")" ::: "memory")
#define PG8_BAR __builtin_amdgcn_s_barrier()
#define PG8_SCHED __builtin_amdgcn_sched_barrier(0)
    Unit cur, nxt; int ui = 0;
    if (!S.next(0, cur)) return;
    f32x4 acc[2][2][4][2];
#pragma unroll
    for (int a = 0; a < 2; ++a)
#pragma unroll
        for (int b = 0; b < 2; ++b)
#pragma unroll
            for (int m = 0; m < 4; ++m)
#pragma unroll
                for (int n = 0; n < 2; ++n) acc[a][b][m][n] = (f32x4){0.f, 0.f, 0.f, 0.f};
    const int one8 = 0x7f7f7f7f;
    bf16x8 At[4][2], B0[2][2], B1[2][2]; i32x8 At8[4], B08[2], B18[2];
    const char* cA = S.aptr(cur); const char* cB = S.bptr(cur);
    S.a_ready(cur);
    if constexpr (SP2) {
        PG8_STAGE(PG8_SB(0, 0), cB, voffB); PG8_STAGE(PG8_SB(0, 1), cB + hstep, voffB); PG8_STAGE(PG8_SA(0, 0), cA, voffA); PG8_STAGE(PG8_SA(0, 1), cA + hstep, voffA);
        if (wr == 1) PG8_BAR;
        PG8_WAIT_V(2); PG8_BAR;
        PG8_STAGE(PG8_SB(1, 0), cB + kstep, voffB); PG8_STAGE(PG8_SA(1, 0), cA + kstep, voffA); PG8_STAGE(PG8_SB(1, 1), cB + hstep + kstep, voffB);
        PG8_WAIT_V(6); PG8_BAR;
    } else {
        PG8_STAGE(PG8_SB(0, 0), cB, voffB); PG8_STAGE(PG8_SA(0, 0), cA, voffA); PG8_STAGE(PG8_SB(0, 1), cB + hstep, voffB); PG8_STAGE(PG8_SA(0, 1), cA + hstep, voffA);
        if (wr == 1) PG8_BAR;
        PG8_WAIT_V(4); PG8_BAR;
        PG8_STAGE(PG8_SB(1, 0), cB + kstep, voffB); PG8_STAGE(PG8_SA(1, 0), cA + kstep, voffA); PG8_STAGE(PG8_SB(1, 1), cB + hstep + kstep, voffB);
        PG8_WAIT_V(6); PG8_BAR;
    }
    for (;;) {
        const bool has_next = S.next(ui + 1, nxt);
        const char* nA = has_next ? S.aptr(nxt) : cA; const char* nB = has_next ? S.bptr(nxt) : cB;
        for (int t = 0; t < nt; t += 2) {
            const bool last = (t == nt - 2);
            const char* a1 = cA + (size_t)(t + 1) * kstep;
            const char* a2 = last ? nA : cA + (size_t)(t + 2) * kstep; const char* b2 = last ? nB : cB + (size_t)(t + 2) * kstep;
            const char* a3 = a2 + kstep; const char* b3 = b2 + kstep;
            if (last && has_next) S.a_ready(nxt);
            if constexpr (SP2) {
            PG8_LDB(B0, 0, 0); PG8_LDB(B1, 0, 1); PG8_SCHED; PG8_LDA(At, 0, 0); PG8_STAGE(PG8_SA(1, 1), a1 + hstep, voffA);
            PG8_WAIT_V(8); PG8_WAIT_L(0); PG8_BAR; PG8_MMA(0, 0, At, B0); PG8_MMA(0, 1, At, B1); PG8_BAR; PG8_SCHED;
            PG8_LDA(At, 0, 1); PG8_STAGE(PG8_SB(0, 0), b2, voffB); PG8_STAGE(PG8_SB(0, 1), b2 + hstep, voffB); PG8_STAGE(PG8_SA(0, 0), a2, voffA);
            PG8_WAIT_V(8); PG8_WAIT_L(0); PG8_BAR; PG8_MMA(1, 0, At, B0); PG8_MMA(1, 1, At, B1); PG8_BAR; PG8_SCHED;
            PG8_LDB(B0, 1, 0); PG8_LDB(B1, 1, 1); PG8_SCHED; PG8_LDA(At, 1, 0); PG8_STAGE(PG8_SA(0, 1), a2 + hstep, voffA);
            PG8_WAIT_V(8); PG8_WAIT_L(0); PG8_BAR; PG8_MMA(0, 0, At, B0); PG8_MMA(0, 1, At, B1); PG8_BAR; PG8_SCHED;
            PG8_LDA(At, 1, 1); PG8_STAGE(PG8_SB(1, 0), b3, voffB); PG8_STAGE(PG8_SB(1, 1), b3 + hstep, voffB); PG8_STAGE(PG8_SA(1, 0), a3, voffA);
            PG8_WAIT_V(8); PG8_WAIT_L(0); PG8_BAR; PG8_MMA(1, 0, At, B0); PG8_MMA(1, 1, At, B1); PG8_BAR; PG8_SCHED;
            } else {
            PG8_LDB(B0, 0, 0); PG8_SCHED; PG8_LDA(At, 0, 0); PG8_STAGE(PG8_SA(1, 1), a1 + hstep, voffA);
            PG8_WAIT_L(8); PG8_BAR; PG8_WAIT_L(0); PG8_MMA(0, 0, At, B0); PG8_BAR; PG8_SCHED;
            PG8_LDB(B1, 0, 1); PG8_STAGE(PG8_SB(0, 0), b2, voffB);
            PG8_BAR; PG8_WAIT_L(0); PG8_MMA(0, 1, At, B1); PG8_BAR;
            PG8_LDA(At, 0, 1); PG8_STAGE(PG8_SA(0, 0), a2, voffA);
            PG8_BAR; PG8_WAIT_L(0); PG8_MMA(1, 0, At, B0); PG8_BAR; PG8_SCHED;
            PG8_STAGE(PG8_SB(0, 1), b2 + hstep, voffB);
            PG8_WAIT_V(6); PG8_BAR; PG8_MMA(1, 1, At, B1); PG8_BAR;
            PG8_LDB(B0, 1, 0); PG8_SCHED; PG8_LDA(At, 1, 0); PG8_STAGE(PG8_SA(0, 1), a2 + hstep, voffA);
            PG8_WAIT_L(8); PG8_BAR; PG8_WAIT_L(0); PG8_MMA(0, 0, At, B0); PG8_BAR; PG8_SCHED;
            PG8_LDB(B1, 1, 1); PG8_STAGE(PG8_SB(1, 0), b3, voffB);
            PG8_BAR; PG8_WAIT_L(0); PG8_MMA(0, 1, At, B1); PG8_BAR;
            PG8_LDA(At, 1, 1); PG8_STAGE(PG8_SA(1, 0), a3, voffA);
            PG8_BAR; PG8_WAIT_L(0); PG8_MMA(1, 0, At, B0); PG8_BAR; PG8_SCHED;
            PG8_STAGE(PG8_SB(1, 1), b3 + hstep, voffB);
            PG8_WAIT_V(6); PG8_BAR; PG8_MMA(1, 1, At, B1); PG8_BAR;
            }
        }
        if constexpr (F8) asm volatile("s_nop 15\n\ts_nop 15\n\ts_nop 15" ::: "memory");
        if constexpr (ALIGN_EPI) { if (wr == 0) PG8_BAR; }
        if constexpr (!Epi::AFTER_DRAIN) { E(acc, cur, wr, wc, fr, fq); S.done(cur); }
        if (!has_next) break;
#pragma unroll
        for (int a = 0; a < 2; ++a)
#pragma unroll
            for (int b = 0; b < 2; ++b)
#pragma unroll
                for (int m = 0; m < 4; ++m)
#pragma unroll
                    for (int n = 0; n < 2; ++n) acc[a][b][m][n] = (f32x4){0.f, 0.f, 0.f, 0.f};
        cur = nxt; cA = nA; cB = nB; ++ui;
        if constexpr (ALIGN_EPI) { if (wr == 1) PG8_BAR; }
    }
    PG8_WAIT_V(0);
    if constexpr (!ALIGN_EPI) { if (wr == 0) PG8_BAR; }
    PG8_BAR;
    if constexpr (Epi::AFTER_DRAIN) { E.fused(acc, cur, wr, wc, fr, fq, lds, wid, lane); S.done(cur); }
#undef PG8_SA
#undef PG8_SB
#undef PG8_STAGE
#undef PG8_LDA
#undef PG8_LDB
#undef PG8_MMA
#undef PG8_LD8
#undef PG8_WAIT_V
#undef PG8_WAIT_L
#undef PG8_BAR
#undef PG8_SCHED
}
}

constexpr int BATCH = 8, SEQ = 2048, D = 2048, M = BATCH * SEQ, NH = 16, HD = 128, NQKV = 6144, NIN = 6150, DFF = 7168, NE = 8, NMOD = 6 * D;
constexpr int MAXT = 136;
constexpr float RMS_EPS = 1e-6f;
constexpr float QSCALE = 0.08838834764831845f * 1.4426950408889634f;
constexpr float LOG2E = 1.4426950408889634f;
constexpr int NWAVES = 8, NTHREADS = 512;
constexpr float W8_SCALE_GU = 64.0f, W8_SCALE_D = 128.0f;

constexpr size_t MiB = 1u << 20;
constexpr size_t WS_CTL = 0, CTL_ZERO_BYTES = 2 * MiB;
constexpr int CW_TMO = 0, CW_BAR = 4096;
constexpr size_t CTL_KM = 256 * 1024;
constexpr size_t WS_MODP = 2 * MiB;
constexpr size_t WS_MOD = 14 * MiB;
constexpr size_t WS_ROPE = 15 * MiB;
constexpr size_t WS_LOGF = 17 * MiB, WS_FB = 17 * MiB + 512 * 1024;
constexpr size_t WS_WFG = 18 * MiB, WS_WRT = 18 * MiB + 256 * 1024;
constexpr size_t WS_TOPE = 19 * MiB, WS_TOPP = WS_TOPE + 256 * 1024, WS_SLOT = WS_TOPE + 512 * 1024, WS_CNT = WS_TOPE + 768 * 1024, WS_META = WS_CNT + 16 * 1024;
constexpr size_t WS_WIN = 20 * MiB;
constexpr size_t WS_WOUT = 68 * MiB;
constexpr size_t WS_WGU = 84 * MiB;
constexpr size_t WS_WD = 140 * MiB;
constexpr size_t WS_EGU = 168 * MiB;
constexpr size_t WS_ED = 616 * MiB;
constexpr size_t WS_HB = 840 * MiB;
constexpr size_t WS_Y = 904 * MiB;
constexpr size_t WS_BIG = 968 * MiB;
constexpr size_t WS_AS = 1444 * MiB;
constexpr size_t WS_PART = 1580 * MiB;
constexpr size_t PART_STRIDE = (size_t)16 * 256 * D;
constexpr size_t WS_X16 = 1648 * MiB;
constexpr size_t WS_END = 1712 * MiB;
constexpr size_t SZ_WGU = (size_t)2 * DFF * D * 2, SZ_WD = (size_t)D * DFF * 2;
constexpr size_t SZ_EGU8 = (size_t)2 * DFF * D, SZ_ED8 = (size_t)D * DFF;

constexpr int LDS_BYTES = 155648;
constexpr int MISC_OFF = 135168;
static_assert(MISC_OFF + 4096 <= LDS_BYTES, "LDS map");

#define GAS __attribute__((address_space(1)))
#define LAS __attribute__((address_space(3)))
typedef unsigned short bf16;
typedef float f32x4 __attribute__((ext_vector_type(4)));
typedef unsigned u32x4 __attribute__((ext_vector_type(4)));
typedef unsigned u32x2 __attribute__((ext_vector_type(2)));
#define LDS_WAIT() asm volatile("s_waitcnt lgkmcnt(0)" ::: "memory")
#define VM_WAIT() asm volatile("s_waitcnt vmcnt(0)" ::: "memory")
__device__ __forceinline__ unsigned pk2(float lo, float hi) { return pg8::cvt_pk_bf16(lo, hi); }
__device__ __forceinline__ float bf_lo(unsigned w) { return __uint_as_float(w << 16); }
__device__ __forceinline__ float bf_hi(unsigned w) { return __uint_as_float(w & 0xffff0000u); }
#define SWZ_XOR(v, X) __builtin_bit_cast(float, __builtin_amdgcn_ds_swizzle(__builtin_bit_cast(int, (float)(v)), (((X) << 10) | 0x1F)))
__device__ __forceinline__ float wave_sum(float v) {
    v += SWZ_XOR(v, 1); v += SWZ_XOR(v, 2); v += SWZ_XOR(v, 4); v += SWZ_XOR(v, 8); v += SWZ_XOR(v, 16);
    const auto rr = __builtin_amdgcn_permlane32_swap(__float_as_uint(v), __float_as_uint(v), false, false);
    return __uint_as_float(rr[0]) + __uint_as_float(rr[1]);
}

#define XB_TMO      128
#define XB_XCNT(j)  (256  + 64 * (j))
#define XB_XSUB(j)  (1280 + 64 * (j))
#define XB_XGEN(j)  (2304 + 64 * (j))
#define XB_TOP      3328
#define XB_TOPGEN   3392
#define XCD_BAR_WORDS 3456
#define XB_SPIN_CAP (1u << 22)

__device__ __forceinline__ unsigned xb_ld(unsigned* p)              { return __hip_atomic_load(p, __ATOMIC_RELAXED, __HIP_MEMORY_SCOPE_AGENT); }
__device__ __forceinline__ unsigned xb_add(unsigned* p, unsigned v) { return __hip_atomic_fetch_add(p, v, __ATOMIC_RELAXED, __HIP_MEMORY_SCOPE_AGENT); }
__device__ __forceinline__ unsigned xb_xcc_id() { return (unsigned)__builtin_amdgcn_s_getreg((3 << 11) | 20) & 0xFu; }
#define XB_SPIN(cond, bar) do { unsigned _sp = 0; while (cond) { __builtin_amdgcn_s_sleep(1); \
    if ((++_sp & 255u) == 0u) { if (xb_ld(&(bar)[XB_TMO])) break; if (_sp > XB_SPIN_CAP) { atomicAdd(&(bar)[XB_TMO], 1u); break; } } } } while (0)

struct XcdBarrier {
    unsigned* bar; unsigned x;
    volatile LAS unsigned* st;
};

__device__ __forceinline__ XcdBarrier xcd_barrier_post(unsigned* bar, volatile LAS unsigned* st) {
    XcdBarrier b; b.bar = bar; b.x = xb_xcc_id(); b.st = st;
    if (threadIdx.x == 0) (void)xb_add(&bar[XB_XCNT(b.x)], 1u);
    return b;
}
__device__ __forceinline__ void xcd_barrier_complete(unsigned* bar, unsigned x, unsigned& nloc, unsigned& nx) {
    const unsigned G = gridDim.x * gridDim.y * gridDim.z;
    unsigned sum, cnt, mine, sp = 0u;
    for (;;) {
        sum = 0u; cnt = 0u; mine = 0u;
#pragma unroll
        for (unsigned j = 0; j < 16; ++j) { const unsigned c = xb_ld(&bar[XB_XCNT(j)]); sum += c; cnt += (c > 0u) ? 1u : 0u; mine = (j == x) ? c : mine; }
        if (sum == G) break;
        __builtin_amdgcn_s_sleep(1);
        if ((++sp & 255u) == 0u) { if (xb_ld(&bar[XB_TMO])) break; if (sp > XB_SPIN_CAP) { atomicAdd(&bar[XB_TMO], 1u); break; } }
    }
    nloc = mine > 0u ? mine : 1u; nx = cnt > 0u ? cnt : 1u;
}

__device__ __forceinline__ void xcd_barrier(const XcdBarrier& b) {
    asm volatile("s_waitcnt vmcnt(0)" ::: "memory");
    __syncthreads();
    if (threadIdx.x == 0) {
        unsigned* bar = b.bar;
        __builtin_amdgcn_s_waitcnt(0);
        unsigned nloc = b.st[0], nx = b.st[1];
        if (nloc == 0u) { xcd_barrier_complete(bar, b.x, nloc, nx); b.st[0] = nloc; b.st[1] = nx; }
        const unsigned old = xb_add(&bar[XB_XSUB(b.x)], 1u);
        const unsigned gen = old / nloc;
        if (old + 1u == (gen + 1u) * nloc) {
            __builtin_amdgcn_fence(__ATOMIC_RELEASE, "agent");
            asm volatile("s_waitcnt vmcnt(0)" ::: "memory");
            const unsigned og = xb_add(&bar[XB_TOP], 1u);
            const unsigned tg = og / nx;
            if (og + 1u == (tg + 1u) * nx) xb_add(&bar[XB_TOPGEN], 1u);
            else XB_SPIN(xb_ld(&bar[XB_TOPGEN]) == tg, bar);
            __builtin_amdgcn_fence(__ATOMIC_ACQUIRE, "agent");
            xb_add(&bar[XB_XGEN(b.x)], 1u);
            asm volatile("s_waitcnt vmcnt(0)" ::: "memory");
        } else {
            XB_SPIN(xb_ld(&bar[XB_XGEN(b.x)]) == gen, bar);
            __builtin_amdgcn_fence(__ATOMIC_ACQUIRE, "agent");
            asm volatile("s_waitcnt vmcnt(0)" ::: "memory");
        }
    }
    __syncthreads();
}
struct Args { const void* in[20]; float* out; unsigned char* ws; int ph_lo, ph_hi; };
struct Frame {
    LAS unsigned char* lds; int tid, lane, wave, blk, G;
    unsigned char* ws;
};
typedef const __attribute__((address_space(4))) Args* KArgs;
__device__ __forceinline__ KArgs kargs() { KArgs p = (KArgs)__builtin_amdgcn_kernarg_segment_ptr(); asm volatile("" : "+s"(p)); return p; }

typedef float f32x2 __attribute__((ext_vector_type(2)));
template <int VEC>
__device__ __forceinline__ void tr_item(const float* src, size_t ld, int K, bf16* dst, int k0, int ncol0, int drow0, LAS float* scr, int lane) {
    if constexpr (VEC == 4) {
        const int r = lane >> 4, c4 = (lane & 15) * 4;
        const float* sp = src + (size_t)(k0 + r) * ld + ncol0 + c4;
#pragma unroll
        for (int i = 0; i < 16; ++i) { const f32x4 v = *(const f32x4*)(sp + (size_t)(4 * i) * ld);
            LAS float* s = scr + (4 * i + r) * 65 + c4; s[0] = v[0]; s[1] = v[1]; s[2] = v[2]; s[3] = v[3]; }
    } else {
        const int r = lane >> 5, c2 = (lane & 31) * 2;
        const float* sp = src + (size_t)(k0 + r) * ld + ncol0 + c2;
#pragma unroll
        for (int i = 0; i < 32; ++i) { const f32x2 v = *(const f32x2*)(sp + (size_t)(2 * i) * ld);
            LAS float* s = scr + (2 * i + r) * 65 + c2; s[0] = v[0]; s[1] = v[1]; }
    }
    LDS_WAIT(); asm volatile("" ::: "memory");
    const int c = lane & 7, nn = lane >> 3;
#pragma unroll
    for (int j = 0; j < 8; ++j) { const int n = nn + 8 * j; const LAS float* s = scr + (8 * c) * 65 + n;
        u32x4 o; o.x = pk2(s[0], s[65]); o.y = pk2(s[2 * 65], s[3 * 65]); o.z = pk2(s[4 * 65], s[5 * 65]); o.w = pk2(s[6 * 65], s[7 * 65]);
        *(u32x4*)(dst + (size_t)(drow0 + n) * K + k0 + 8 * c) = o; }
    LDS_WAIT(); asm volatile("" ::: "memory");
}

__device__ __forceinline__ void tr_item8(const float* src, size_t ld, int K, unsigned char* dst, int k0, int ncol0, int drow0, float wscale, LAS float* scr, int lane) {
    { const int r = lane >> 4, c4 = (lane & 15) * 4;
      const float* sp = src + (size_t)(k0 + r) * ld + ncol0 + c4;
#pragma unroll
      for (int i = 0; i < 16; ++i) { const f32x4 v = *(const f32x4*)(sp + (size_t)(4 * i) * ld);
          LAS float* s = scr + (4 * i + r) * 65 + c4; s[0] = v[0] * wscale; s[1] = v[1] * wscale; s[2] = v[2] * wscale; s[3] = v[3] * wscale; } }
    LDS_WAIT(); asm volatile("" ::: "memory");
    const int c = lane & 3, nn = lane >> 2;
#pragma unroll
    for (int j = 0; j < 4; ++j) { const int n = nn + 16 * j; const LAS float* s = scr + (16 * c) * 65 + n;
        u32x4 o; o.x = pg8::pk4_fp8(s[0], s[65], s[2 * 65], s[3 * 65]); o.y = pg8::pk4_fp8(s[4 * 65], s[5 * 65], s[6 * 65], s[7 * 65]);
        o.z = pg8::pk4_fp8(s[8 * 65], s[9 * 65], s[10 * 65], s[11 * 65]); o.w = pg8::pk4_fp8(s[12 * 65], s[13 * 65], s[14 * 65], s[15 * 65]);
        *(u32x4*)(dst + (size_t)(drow0 + n) * K + k0 + 16 * c) = o; }
    LDS_WAIT(); asm volatile("" ::: "memory");
}
__device__ __forceinline__ void sincos_d(double a, float& c, float& s) {
    const double n = __builtin_rint(a * 0.15915494309189535);
    double r = __builtin_fma(-n, 6.283185307179586, a); r = __builtin_fma(-n, 2.4492935982947064e-16, r);
    const double r2 = r * r;
    double sp = -1.0 / 25852016738884976640000.0;
    sp = sp * r2 + 1.0 / 51090942171709440000.0;
    sp = sp * r2 - 1.0 / 121645100408832000.0;
    sp = sp * r2 + 1.0 / 355687428096000.0;
    sp = sp * r2 - 1.0 / 1307674368000.0;
    sp = sp * r2 + 1.0 / 6227020800.0;
    sp = sp * r2 - 1.0 / 39916800.0;
    sp = sp * r2 + 1.0 / 362880.0;
    sp = sp * r2 - 1.0 / 5040.0;
    sp = sp * r2 + 1.0 / 120.0;
    sp = sp * r2 - 1.0 / 6.0;
    sp = sp * r2 + 1.0;
    double cp = 1.0 / 620448401733239439360000.0;
    cp = cp * r2 - 1.0 / 1124000727777607680000.0;
    cp = cp * r2 + 1.0 / 2432902008176640000.0;
    cp = cp * r2 - 1.0 / 6402373705728000.0;
    cp = cp * r2 + 1.0 / 20922789888000.0;
    cp = cp * r2 - 1.0 / 87178291200.0;
    cp = cp * r2 + 1.0 / 479001600.0;
    cp = cp * r2 - 1.0 / 3628800.0;
    cp = cp * r2 + 1.0 / 40320.0;
    cp = cp * r2 - 1.0 / 720.0;
    cp = cp * r2 + 1.0 / 24.0;
    cp = cp * r2 - 0.5;
    cp = cp * r2 + 1.0;
    c = (float)cp; s = (float)(sp * r);
}
__device__ __forceinline__ double inv_freq_d(int i) {
    const double t[16] = {1.0, 0.44036660267178046, 0.19392274474868576, 0.08539710028576561, 0.03760603093086393, 0.016560440080994446, 0.007292664737217109, 0.003211445994752591,
                          0.001414213562373095, 0.000622772421914596, 0.0002742481756762073, 0.00012076973741146504, 5.318295896944988e-05, 2.341999896140934e-05, 1.031338537721246e-05, 4.5416704806078695e-06};
    double v = t[0];
#pragma unroll
    for (int k = 1; k < 16; ++k) v = (i == k) ? t[k] : v;
    return v;
}


typedef float f32x4u __attribute__((ext_vector_type(4), aligned(8)));
struct ConvStep { const float* src; size_t ld; unsigned char* dst; int kdst, k0, ncol0, drow0, out8; float wscale; };
__device__ __forceinline__ ConvStep conv_decode(KArgs ap, unsigned char* ws, int item, int sub, int wave) {
    ConvStep c; int r = item;
    if (r < 27 * 112) {
        const int mat = r / 112, q = r % 112, set = mat / 3, kind = mat % 3;
        if (kind < 2) { const int strip = q >> 3, kc = q & 7; c.ncol0 = strip * 512 + wave * 64; c.k0 = (kc * 4 + sub) * 64; c.ld = DFF;
            c.src = set == 0 ? (const float*)ap->in[12 + kind] : (const float*)ap->in[17 + kind] + (size_t)(set - 1) * D * DFF;
            c.out8 = set == 0 ? ((DENSE_F8 & 1) ? 1 : 0) : 1; c.wscale = W8_SCALE_GU; c.kdst = c.out8 ? D : 2 * D;
            c.dst = set == 0 ? ws + WS_WGU : ws + WS_EGU + (size_t)(set - 1) * SZ_EGU8; c.drow0 = 256 * (c.ncol0 >> 7) + (c.ncol0 & 127) + kind * 128; }
        else { const int strip = q / 28, kc = q % 28; c.ncol0 = strip * 512 + wave * 64; c.k0 = (kc * 4 + sub) * 64; c.ld = D;
            c.src = set == 0 ? (const float*)ap->in[14] : (const float*)ap->in[19] + (size_t)(set - 1) * DFF * D;
            c.out8 = set == 0 ? ((DENSE_F8 & 2) ? 1 : 0) : 1; c.wscale = W8_SCALE_D; c.kdst = c.out8 ? DFF : 2 * DFF;
            c.dst = set == 0 ? ws + WS_WD : ws + WS_ED + (size_t)(set - 1) * SZ_ED8; c.drow0 = c.ncol0; }
        return c; }
    r -= 27 * 112;
    if (r < 64) { const int l = r >> 5, q = r & 31, strip = q >> 3, kc = q & 7; c.ncol0 = strip * 512 + wave * 64; c.k0 = (kc * 4 + sub) * 64; c.ld = D;
        c.src = (const float*)ap->in[11] + (size_t)l * D * D; c.out8 = 0; c.wscale = 1.f; c.kdst = 2 * D; c.dst = ws + WS_WOUT + (size_t)l * D * D * 2; c.drow0 = c.ncol0; return c; }
    r -= 64;
    { const int l = r / 96, q = r % 96, strip = q >> 3, kc = q & 7; c.ncol0 = strip * 512 + wave * 64; c.k0 = (kc * 4 + sub) * 64; c.ld = NIN;
      c.src = (const float*)ap->in[9] + (size_t)l * D * NIN; c.out8 = 0; c.wscale = 1.f; c.kdst = 2 * D; c.dst = ws + WS_WIN + (size_t)l * NQKV * D * 2; c.drow0 = c.ncol0; return c; }
}
constexpr int CONV_ITEMS = 27 * 112 + 64 + 192;
#define CONV_LOAD(buf, cs) do { const float* sp_ = (cs).src + (size_t)((cs).k0 + 4 * gl_) * (cs).ld + (cs).ncol0 + 4 * c_;                                           \
        _Pragma("unroll") for (int p_ = 0; p_ < 4; ++p_) _Pragma("unroll") for (int q_ = 0; q_ < 4; ++q_)                                                       \
            buf[4 * p_ + q_] = *(const f32x4u*)(sp_ + (size_t)(16 * p_ + q_) * (cs).ld); } while (0)
#define CONV_PROC(buf, cs) do {                                                                                                                                  \
        if ((cs).out8) { const float sc_ = (cs).wscale; const int hf_ = ((cs).k0 >> 6) & 1;        \
            _Pragma("unroll") for (int p_ = 0; p_ < 4; ++p_) _Pragma("unroll") for (int e_ = 0; e_ < 4; ++e_)                                                   \
                T[(4 * c_ + e_) * 33 + 16 * hf_ + 4 * p_ + gl_] = pg8::pk4_fp8(buf[4 * p_][e_] * sc_, buf[4 * p_ + 1][e_] * sc_, buf[4 * p_ + 2][e_] * sc_, buf[4 * p_ + 3][e_] * sc_);   \
            LDS_WAIT(); asm volatile("" ::: "memory");                                                                                                           \
            if (hf_) {                                                                                                                                           \
            _Pragma("unroll") for (int i_ = 0; i_ < 8; ++i_) { const int n_ = 8 * i_ + (lane >> 3), pt_ = lane & 7;         \
                u32x4 o_; o_.x = T[n_ * 33 + 4 * pt_]; o_.y = T[n_ * 33 + 4 * pt_ + 1]; o_.z = T[n_ * 33 + 4 * pt_ + 2]; o_.w = T[n_ * 33 + 4 * pt_ + 3];                                 \
                *(u32x4*)((cs).dst + (size_t)((cs).drow0 + n_) * (cs).kdst + ((cs).k0 - 64) + 16 * pt_) = o_; } }                                                  \
        } else {                                                                                                                                                 \
            _Pragma("unroll") for (int p_ = 0; p_ < 4; ++p_) _Pragma("unroll") for (int e_ = 0; e_ < 4; ++e_) {                                                 \
                T[(4 * c_ + e_) * 33 + 8 * p_ + 2 * gl_] = pk2(buf[4 * p_][e_], buf[4 * p_ + 1][e_]); T[(4 * c_ + e_) * 33 + 8 * p_ + 2 * gl_ + 1] = pk2(buf[4 * p_ + 2][e_], buf[4 * p_ + 3][e_]); } \
            LDS_WAIT(); asm volatile("" ::: "memory");                                                                                                           \
            _Pragma("unroll") for (int i_ = 0; i_ < 8; ++i_) { const int n_ = 8 * i_ + (lane >> 3), pt_ = lane & 7;         \
                u32x4 o_; o_.x = T[n_ * 33 + 4 * pt_]; o_.y = T[n_ * 33 + 4 * pt_ + 1]; o_.z = T[n_ * 33 + 4 * pt_ + 2]; o_.w = T[n_ * 33 + 4 * pt_ + 3];                                 \
                *(u32x4*)((cs).dst + (size_t)((cs).drow0 + n_) * (cs).kdst + (cs).k0 * 2 + 16 * pt_) = o_; }                                                      \
        }                                                                                                                                                        \
        LDS_WAIT(); asm volatile("" ::: "memory"); } while (0)
__device__ __forceinline__ void conv_all(const Frame& F, KArgs ap) {
    LAS unsigned* T = (LAS unsigned*)(F.lds + F.wave * 8448);
    const int lane = F.lane, c_ = lane & 15, gl_ = lane >> 4;
    int nit = 0; for (int it = F.blk; it < CONV_ITEMS; it += F.G) ++nit;
    const int nsteps = nit * 4; if (nsteps == 0) return;
    f32x4 A[16], B[16];
    ConvStep ca = conv_decode(ap, F.ws, F.blk, 0, F.wave), cb = ca;
    CONV_LOAD(A, ca);
    for (int u = 0; u < nsteps; u += 2) {
        { const int un = u + 1; cb = conv_decode(ap, F.ws, F.blk + (un >> 2) * F.G, un & 3, F.wave); CONV_LOAD(B, cb); }
        CONV_PROC(A, ca);
        if (u + 2 < nsteps) { const int un = u + 2; ca = conv_decode(ap, F.ws, F.blk + (un >> 2) * F.G, un & 3, F.wave); CONV_LOAD(A, ca); }
        CONV_PROC(B, cb);
    }
}
#undef CONV_LOAD
#undef CONV_PROC

__device__ __forceinline__ void phase_prologue_a(const Frame& F0, KArgs ap) {
    Frame F = F0; asm volatile("" : "+v"(F.tid)); F.lane = F.tid & 63;
    const float* c_in = (const float*)ap->in[1]; const int* pos = (const int*)ap->in[2];
    const float* w_mod = (const float*)ap->in[7]; const float* w_in = (const float*)ap->in[9]; const float* w_out = (const float*)ap->in[11];
    const float* w_router = (const float*)ap->in[15];
    const int gw = F.blk * NWAVES + F.wave, NGW = F.G * NWAVES, gt = F.blk * NTHREADS + F.tid, NGT = F.G * NTHREADS;
    LAS float* condL = (LAS float*)(F.lds + 69632);
    { float cv[BATCH * D / NTHREADS];
#pragma unroll
      for (int j = 0; j < BATCH * D / NTHREADS; ++j) cv[j] = c_in[F.tid + j * NTHREADS];
#pragma unroll
      for (int j = 0; j < BATCH * D / NTHREADS; ++j) { const int i = F.tid + j * NTHREADS, b = i >> 11, k = i & 2047; const float v = cv[j]; condL[k * 8 + b] = v / (1.0f + __expf(-v)); } }
    __syncthreads();
    for (int it = gw; it < 2 * 48 * 16; it += NGW) {
        const int l = it / 768, r = it % 768, cg = r >> 4, kc = r & 15, col4 = cg * 256 + F.lane * 4;
        f32x4 acc[8];
#pragma unroll
        for (int b = 0; b < 8; ++b) acc[b] = (f32x4){0.f, 0.f, 0.f, 0.f};
        const float* wp = w_mod + ((size_t)l * D + kc * 128) * NMOD + col4;
#pragma unroll 8
        for (int k = 0; k < 128; ++k) { const f32x4 w = *(const f32x4*)(wp + (size_t)k * NMOD); const LAS f32x4* cp = (const LAS f32x4*)(condL + (kc * 128 + k) * 8); const f32x4 c0 = cp[0], c1 = cp[1];
            acc[0] += w * c0[0]; acc[1] += w * c0[1]; acc[2] += w * c0[2]; acc[3] += w * c0[3]; acc[4] += w * c1[0]; acc[5] += w * c1[1]; acc[6] += w * c1[2]; acc[7] += w * c1[3]; }
        float* mp = (float*)(F.ws + WS_MODP) + ((size_t)(kc * 2 + l) * 8) * NMOD + col4;
#pragma unroll
        for (int b = 0; b < 8; ++b) *(f32x4*)(mp + (size_t)b * NMOD) = acc[b];
    }
    { float* rope = (float*)(F.ws + WS_ROPE);
      for (int i = gt; i < M * 16; i += NGT) { const int tok = i >> 4, j = i & 15; float cs, sn; sincos_d((double)pos[tok] * inv_freq_d(j), cs, sn); rope[tok * 32 + j] = cs; rope[tok * 32 + 16 + j] = sn; }
      float* wfg = (float*)(F.ws + WS_WFG);
      for (int i = gt; i < 2 * 6 * D; i += NGT) { const int l = i / (6 * D), r = i % (6 * D), q = r >> 11, k = r & 2047; wfg[i] = w_in[((size_t)l * D + k) * NIN + NQKV + q]; }
      float* wrt = (float*)(F.ws + WS_WRT);
      for (int i = gt; i < NE * D; i += NGT) { const int e = i >> 11, k = i & 2047; wrt[i] = w_router[k * NE + e]; } }
    conv_all(F, ap);
    __syncthreads();
}
__device__ __forceinline__ void phase_prologue_b(const Frame& F0, KArgs ap) {
    Frame F = F0; asm volatile("" : "+v"(F.tid)); F.lane = F.tid & 63;
    const float* b_mod = (const float*)ap->in[8]; const float* mp = (const float*)(F.ws + WS_MODP); float* mod = (float*)(F.ws + WS_MOD);
    for (int i = F.blk * NTHREADS + F.tid; i < 2 * BATCH * NMOD; i += F.G * NTHREADS) { const int l = i / (BATCH * NMOD), r = i % (BATCH * NMOD), col = r % NMOD;
        float s = b_mod[l * NMOD + col];
#pragma unroll
        for (int kc = 0; kc < 16; ++kc) s += mp[(size_t)(kc * 2 + l) * (BATCH * NMOD) + r];
        mod[i] = s; }
}
struct RowArgs {
    int has_post, moe_y, has_pre, fg, router, out8;
    const float* xin; float* xout; const bf16* Y; const int* slot; const float* topp; const float* gvec; const float* lnpost;
    const float* lnpre; const float* sh; const float* sc; bf16* hout;
    const float* wfg; const float* bfg; float* logf;
    const float* wrt; const float* brt; int* tope; float* topp_out; int* cnt;
    const bf16* part; int split_base, nsplit;
    const bf16* xin16; bf16* xout16;
};
__device__ __forceinline__ void phase_rows(const Frame& F0, const RowArgs& R) {
    Frame F = F0; asm volatile("" : "+v"(F.tid)); F.lane = F.tid & 63;
    LAS float* VL = (LAS float*)F.lds;
    LAS int* hist = (LAS int*)(F.lds + MISC_OFF + 64);
    const int b = (F.blk * 64) >> 11;
    { const int t = F.tid;
      if (R.has_post) { ((LAS f32x4*)VL)[t] = ((const f32x4*)(R.gvec + (size_t)b * NMOD))[t]; ((LAS f32x4*)(VL + 2048))[t] = ((const f32x4*)R.lnpost)[t]; }
      if (R.has_pre) { ((LAS f32x4*)(VL + 4096))[t] = ((const f32x4*)R.lnpre)[t]; ((LAS f32x4*)(VL + 6144))[t] = ((const f32x4*)(R.sc + (size_t)b * NMOD))[t] + 1.0f; ((LAS f32x4*)(VL + 8192))[t] = ((const f32x4*)(R.sh + (size_t)b * NMOD))[t]; }
      if (R.fg) {
#pragma unroll
          for (int q = 0; q < 6; ++q) ((LAS f32x4*)(VL + 10240 + q * 2048))[t] = ((const f32x4*)(R.wfg + (size_t)q * D))[t]; }
      if (R.router) {
#pragma unroll
          for (int e = 0; e < 8; ++e) ((LAS f32x4*)(VL + 10240 + e * 2048))[t] = ((const f32x4*)(R.wrt + (size_t)e * D))[t];
          if (t < 8) hist[t] = 0; } }
    __syncthreads();
    for (int ip = 0; ip < 4; ++ip) {
        int lane = F.lane; asm volatile("" : "+v"(lane));
        const int row0 = F.blk * 64 + F.wave * 8 + 2 * ip;
        const LAS f32x4* VV = (const LAS f32x4*)VL + lane;
        f32x4 v[2][8];
        if (R.has_post) {
            f32x4 y[2][8]; float ss[2];
#pragma unroll
            for (int r = 0; r < 2; ++r) { const int row = row0 + r;
                if (!R.moe_y) { const u32x2* yr = (const u32x2*)(R.Y + (size_t)row * D) + lane;
#pragma unroll
                    for (int j = 0; j < 8; ++j) { const u32x2 w = yr[64 * j]; y[r][j] = (f32x4){bf_lo(w.x), bf_hi(w.x), bf_lo(w.y), bf_hi(w.y)}; } }
                else { const int s1 = R.slot[2 * row], s2 = R.slot[2 * row + 1]; const float p1 = R.topp[2 * row], p2 = R.topp[2 * row + 1];
#pragma unroll
                    for (int j = 0; j < 8; ++j) y[r][j] = (f32x4){0.f, 0.f, 0.f, 0.f};
#pragma unroll
                    for (int q = 0; q < 2; ++q) { const int sq = q ? s2 : s1; const float pq = q ? p2 : p1;
                        if (sq < R.split_base) { const u32x2* yq = (const u32x2*)(R.Y + (size_t)sq * D) + lane;
#pragma unroll
                            for (int j = 0; j < 8; ++j) { const u32x2 w = yq[64 * j]; y[r][j] += (f32x4){bf_lo(w.x), bf_hi(w.x), bf_lo(w.y), bf_hi(w.y)} * pq; } }
                        else { for (int ks = 0; ks < R.nsplit; ++ks) { const u32x2* yq = (const u32x2*)(R.part + (size_t)ks * PART_STRIDE + (size_t)(sq - R.split_base) * D) + lane;
#pragma unroll
                            for (int j = 0; j < 8; ++j) { const u32x2 w = yq[64 * j]; y[r][j] += (f32x4){bf_lo(w.x), bf_hi(w.x), bf_lo(w.y), bf_hi(w.y)} * pq; } } } } }
                if (R.xin16) { const u32x2* xr = (const u32x2*)(R.xin16 + (size_t)row * D) + lane;
#pragma unroll
                    for (int j = 0; j < 8; ++j) { const u32x2 w = xr[64 * j]; v[r][j] = (f32x4){bf_lo(w.x), bf_hi(w.x), bf_lo(w.y), bf_hi(w.y)}; } }
                else { const f32x4* xr = (const f32x4*)(R.xin + (size_t)row * D) + lane;
#pragma unroll
                    for (int j = 0; j < 8; ++j) v[r][j] = xr[64 * j]; } }
            asm volatile("" ::: "memory");
#pragma unroll
            for (int r = 0; r < 2; ++r) { float s = 0.f;
#pragma unroll
                for (int j = 0; j < 8; ++j) s += (y[r][j][0] * y[r][j][0] + y[r][j][1] * y[r][j][1]) + (y[r][j][2] * y[r][j][2] + y[r][j][3] * y[r][j][3]);
                ss[r] = s; }
            const float rs0 = 1.0f / sqrtf(wave_sum(ss[0]) * (1.0f / D) + RMS_EPS), rs1 = 1.0f / sqrtf(wave_sum(ss[1]) * (1.0f / D) + RMS_EPS);
            asm volatile("" ::: "memory");
#pragma unroll
            for (int j = 0; j < 8; ++j) { const f32x4 g = VV[64 * j], lp = VV[512 + 64 * j];
                v[0][j] = v[0][j] + g * ((y[0][j] * rs0) * lp); v[1][j] = v[1][j] + g * ((y[1][j] * rs1) * lp); }
#pragma unroll
            for (int r = 0; r < 2; ++r) {
                if (R.xout16) { u32x2* xo = (u32x2*)(R.xout16 + (size_t)(row0 + r) * D) + lane;
#pragma unroll
                    for (int j = 0; j < 8; ++j) { u32x2 w; w.x = pk2(v[r][j][0], v[r][j][1]); w.y = pk2(v[r][j][2], v[r][j][3]); xo[64 * j] = w;
                        v[r][j] = (f32x4){bf_lo(w.x), bf_hi(w.x), bf_lo(w.y), bf_hi(w.y)}; } }
                else { f32x4* xo = (f32x4*)(R.xout + (size_t)(row0 + r) * D) + lane;
#pragma unroll
                    for (int j = 0; j < 8; ++j) xo[64 * j] = v[r][j]; } }
        } else {
#pragma unroll
            for (int r = 0; r < 2; ++r) { const f32x4* xr = (const f32x4*)(R.xin + (size_t)(row0 + r) * D) + lane;
#pragma unroll
                for (int j = 0; j < 8; ++j) v[r][j] = xr[64 * j]; } }
        if (R.has_pre) {
            float ss[2];
#pragma unroll
            for (int r = 0; r < 2; ++r) { float s = 0.f;
#pragma unroll
                for (int j = 0; j < 8; ++j) s += (v[r][j][0] * v[r][j][0] + v[r][j][1] * v[r][j][1]) + (v[r][j][2] * v[r][j][2] + v[r][j][3] * v[r][j][3]);
                ss[r] = s; }
            const float rs0 = 1.0f / sqrtf(wave_sum(ss[0]) * (1.0f / D) + RMS_EPS), rs1 = 1.0f / sqrtf(wave_sum(ss[1]) * (1.0f / D) + RMS_EPS);
            asm volatile("" ::: "memory");
#pragma unroll
            for (int j = 0; j < 8; ++j) { const f32x4 lr = VV[1024 + 64 * j], s1p = VV[1536 + 64 * j], sh = VV[2048 + 64 * j];
                v[0][j] = ((v[0][j] * rs0) * lr) * s1p + sh; v[1][j] = ((v[1][j] * rs1) * lr) * s1p + sh; }
#pragma unroll
            for (int r = 0; r < 2; ++r) { const int row = row0 + r;
#pragma unroll
                for (int j = 0; j < 8; ++j) {
                    if (R.out8) { ((unsigned*)((unsigned char*)R.hout + (size_t)row * D) + lane)[64 * j] = pg8::pk4_fp8(v[r][j][0], v[r][j][1], v[r][j][2], v[r][j][3]); }
                    else { u32x2 w; w.x = pk2(v[r][j][0], v[r][j][1]); w.y = pk2(v[r][j][2], v[r][j][3]); ((u32x2*)(R.hout + (size_t)row * D) + lane)[64 * j] = w; } } }
            if (R.fg) {
                float d0[6], d1[6];
#pragma unroll
                for (int q = 0; q < 6; ++q) { float s0 = 0.f, s1 = 0.f;
#pragma unroll
                    for (int j = 0; j < 8; ++j) { const f32x4 w = VV[2560 + q * 512 + 64 * j];
                        s0 += (v[0][j][0] * w[0] + v[0][j][1] * w[1]) + (v[0][j][2] * w[2] + v[0][j][3] * w[3]); s1 += (v[1][j][0] * w[0] + v[1][j][1] * w[1]) + (v[1][j][2] * w[2] + v[1][j][3] * w[3]); }
                    d0[q] = wave_sum(s0); d1[q] = wave_sum(s1); }
                if (lane < 12) { const int q = lane < 6 ? lane : lane - 6; float z = 0.f;
#pragma unroll
                    for (int k = 0; k < 6; ++k) { z = (lane == k) ? d0[k] : z; z = (lane == k + 6) ? d1[k] : z; }
                    z += R.bfg[q];
                    const float lf = fminf(z, 0.f) - log1pf(__expf(-fabsf(z)));
                    R.logf[((size_t)b * 6 + q) * SEQ + ((row0 + (lane < 6 ? 0 : 1)) & 2047)] = lf; }
            }
            if (R.router) {
#pragma unroll
                for (int r = 0; r < 2; ++r) { const int row = row0 + r;
                    float lg[8];
#pragma unroll
                    for (int e = 0; e < 8; ++e) { float s = 0.f;
#pragma unroll
                        for (int j = 0; j < 8; ++j) { const f32x4 w = VV[2560 + e * 512 + 64 * j]; s += (v[r][j][0] * w[0] + v[r][j][1] * w[1]) + (v[r][j][2] * w[2] + v[r][j][3] * w[3]); }
                        lg[e] = wave_sum(s) + R.brt[e]; }
                    int e1 = 0; float v1 = lg[0];
#pragma unroll
                    for (int e = 1; e < 8; ++e) if (lg[e] > v1) { v1 = lg[e]; e1 = e; }
                    int e2 = -1; float v2 = -3.0e38f;
#pragma unroll
                    for (int e = 0; e < 8; ++e) if (e != e1 && lg[e] > v2) { v2 = lg[e]; e2 = e; }
                    if (lane == 0) { const float p1 = 1.0f / (1.0f + __expf(v2 - v1)); R.tope[2 * row] = e1; R.tope[2 * row + 1] = e2; R.topp_out[2 * row] = p1; R.topp_out[2 * row + 1] = 1.0f - p1;
                        atomicAdd((int*)&hist[e1], 1); atomicAdd((int*)&hist[e2], 1); } }
            }
        }
    }
    __syncthreads();
    if (R.router) { if (F.tid < 8) R.cnt[F.blk * 8 + F.tid] = hist[F.tid]; }
}

__device__ __forceinline__ void phase_scatter(const Frame& F0) {
    Frame F = F0; asm volatile("" : "+v"(F.tid)); F.lane = F.tid & 63;
    LAS int* cntL = (LAS int*)F.lds; LAS int* totL = cntL + 2048; LAS int* preL = totL + 8; LAS int* tsL = preL + 8; LAS int* slotL = tsL + 16;
    const int* cnt = (const int*)(F.ws + WS_CNT); const int* tope = (const int*)(F.ws + WS_TOPE); int* slot = (int*)(F.ws + WS_SLOT); int* meta = (int*)(F.ws + WS_META);
    const bf16* hb = (const bf16*)(F.ws + WS_HB); unsigned char* as = (unsigned char*)(F.ws + WS_AS);
    for (int i = F.tid; i < 2048; i += NTHREADS) cntL[i] = cnt[i];
    __syncthreads();
    { const int e = F.wave; float tot = 0.f, pre = 0.f;
#pragma unroll
      for (int j = 0; j < 4; ++j) { const int c = F.lane + 64 * j; const float v = (float)cntL[c * 8 + e]; pre += (c < F.blk) ? v : 0.f; tot += v; }
      tot = wave_sum(tot); pre = wave_sum(pre);
      if (F.lane == 0) { totL[e] = (int)tot; preL[e] = (int)pre; } }
    __syncthreads();
    if (F.tid == 0) { int t = 0; for (int e = 0; e < 8; ++e) { tsL[e] = t; t += (totL[e] + 255) >> 8; } tsL[8] = t;
        if (F.blk == 0) { for (int e = 0; e <= 8; ++e) meta[e] = tsL[e]; for (int e = 0; e < 8; ++e) meta[9 + e] = totL[e];
            const int r = t & 31, ns = (r == 0 || r > 16) ? 1 : (r <= 8 ? 4 : 2), rs = ns == 1 ? 0 : r;
            meta[20] = rs; meta[21] = ns; meta[22] = (t - rs) * 256; } }
    __syncthreads();
    if (F.wave == 0) { const int tok = F.blk * 64 + F.lane; const int e1 = tope[2 * tok], e2 = tope[2 * tok + 1]; int s1 = 0, s2 = 0;
        const unsigned long long lt = (1ull << F.lane) - 1ull;
#pragma unroll
        for (int e = 0; e < 8; ++e) { const unsigned long long mk = __ballot(e1 == e || e2 == e); const int pos = tsL[e] * 256 + preL[e] + __popcll(mk & lt);
            if (e1 == e) s1 = pos; if (e2 == e) s2 = pos; }
        slot[2 * tok] = s1; slot[2 * tok + 1] = s2; slotL[2 * F.lane] = s1; slotL[2 * F.lane + 1] = s2; }
    __syncthreads();
    { u32x4 ra[8], rb[8], rc[8], rd[8];
#pragma unroll
      for (int i = 0; i < 8; ++i) { const int tok = F.blk * 64 + F.wave * 8 + i; const u32x4* src = (const u32x4*)(hb + (size_t)tok * D) + 2 * F.lane;
          ra[i] = src[0]; rb[i] = src[1]; rc[i] = src[128]; rd[i] = src[129]; }
      asm volatile("" ::: "memory");
#pragma unroll
      for (int i = 0; i < 8; ++i) { const int t = F.wave * 8 + i; const int s1 = slotL[2 * t], s2 = slotL[2 * t + 1];
          u32x4 o0, o1;
          { const u32x4 a = ra[i], b = rb[i];
            o0.x = pg8::pk4_fp8(bf_lo(a.x), bf_hi(a.x), bf_lo(a.y), bf_hi(a.y)); o0.y = pg8::pk4_fp8(bf_lo(a.z), bf_hi(a.z), bf_lo(a.w), bf_hi(a.w));
            o0.z = pg8::pk4_fp8(bf_lo(b.x), bf_hi(b.x), bf_lo(b.y), bf_hi(b.y)); o0.w = pg8::pk4_fp8(bf_lo(b.z), bf_hi(b.z), bf_lo(b.w), bf_hi(b.w)); }
          { const u32x4 a = rc[i], b = rd[i];
            o1.x = pg8::pk4_fp8(bf_lo(a.x), bf_hi(a.x), bf_lo(a.y), bf_hi(a.y)); o1.y = pg8::pk4_fp8(bf_lo(a.z), bf_hi(a.z), bf_lo(a.w), bf_hi(a.w));
            o1.z = pg8::pk4_fp8(bf_lo(b.x), bf_hi(b.x), bf_lo(b.y), bf_hi(b.y)); o1.w = pg8::pk4_fp8(bf_lo(b.z), bf_hi(b.z), bf_lo(b.w), bf_hi(b.w)); }
          u32x4* d1 = (u32x4*)(as + (size_t)s1 * D) + F.lane; u32x4* d2 = (u32x4*)(as + (size_t)s2 * D) + F.lane;
          d1[0] = o0; d1[64] = o1; d2[0] = o0; d2[64] = o1; } }
    { const int e = F.wave; const int npad = (tsL[e + 1] - tsL[e]) * 256 - totL[e];
      if (F.blk < npad) { u32x4* d = (u32x4*)(as + (size_t)(tsL[e] * 256 + totL[e] + F.blk) * D) + F.lane;
          d[0] = (u32x4){0u, 0u, 0u, 0u}; d[64] = (u32x4){0u, 0u, 0u, 0u}; } }
    __syncthreads();
}

__device__ __forceinline__ void fgate_scan(const Frame& F0) {
    Frame F = F0; asm volatile("" : "+v"(F.tid)); F.lane = F.tid & 63;
    if (F.blk < 48 && F.wave == 0) { const float* lf = (const float*)(F.ws + WS_LOGF) + (size_t)F.blk * SEQ + F.lane * 32; float* fb = (float*)(F.ws + WS_FB) + (size_t)F.blk * SEQ + F.lane * 32;
        f32x4 v[8]; float run = 0.f;
#pragma unroll
        for (int j = 0; j < 8; ++j) { v[j] = ((const f32x4*)lf)[j];
#pragma unroll
            for (int k = 0; k < 4; ++k) { run += v[j][k]; v[j][k] = run; } }
        LAS float* tl = (LAS float*)(F.lds + MISC_OFF + 256); tl[F.lane] = run; LDS_WAIT(); asm volatile("" ::: "memory");
        float excl = 0.f;
        for (int k = 0; k < 64; ++k) { const float t = tl[k]; excl += (k < F.lane) ? t : 0.f; }
#pragma unroll
        for (int j = 0; j < 8; ++j) ((f32x4*)fb)[j] = (v[j] + excl) * (-LOG2E); }
}
#define ATT_STEP(KROW, VROW, BIAS, VALID) do {                                                                                              \
        const u32x4* kp_ = (const u32x4*)(KROW); float dot_ = 0.f;                                                                         \
        _Pragma("unroll") for (int c_ = 0; c_ < 4; ++c_) { const u32x4 w_ = kp_[c_];                                                      \
            dot_ += qf[8 * c_ + 0] * bf_lo(w_.x) + qf[8 * c_ + 1] * bf_hi(w_.x) + qf[8 * c_ + 2] * bf_lo(w_.y) + qf[8 * c_ + 3] * bf_hi(w_.y)   \
                  + qf[8 * c_ + 4] * bf_lo(w_.z) + qf[8 * c_ + 5] * bf_hi(w_.z) + qf[8 * c_ + 6] * bf_lo(w_.w) + qf[8 * c_ + 7] * bf_hi(w_.w); }  \
        dot_ += SWZ_XOR(dot_, 1); dot_ += SWZ_XOR(dot_, 2);                                                                           \
        const bool ok_ = (VALID); const float sc_ = dot_ + (BIAS);                                                                          \
        const float mn_ = ok_ ? fmaxf(mrun, sc_) : mrun; const float al_ = __builtin_amdgcn_exp2f(mrun - mn_); const float p_ = ok_ ? __builtin_amdgcn_exp2f(sc_ - mn_) : 0.f;   \
        mrun = mn_; lrun = lrun * al_ + p_;                                                                                                 \
        const u32x4* vp_ = (const u32x4*)(VROW);                                                                                            \
        _Pragma("unroll") for (int c_ = 0; c_ < 4; ++c_) { const u32x4 w_ = vp_[c_];                                                      \
            of[8 * c_ + 0] = of[8 * c_ + 0] * al_ + p_ * bf_lo(w_.x); of[8 * c_ + 1] = of[8 * c_ + 1] * al_ + p_ * bf_hi(w_.x);             \
            of[8 * c_ + 2] = of[8 * c_ + 2] * al_ + p_ * bf_lo(w_.y); of[8 * c_ + 3] = of[8 * c_ + 3] * al_ + p_ * bf_hi(w_.y);             \
            of[8 * c_ + 4] = of[8 * c_ + 4] * al_ + p_ * bf_lo(w_.z); of[8 * c_ + 5] = of[8 * c_ + 5] * al_ + p_ * bf_hi(w_.z);             \
            of[8 * c_ + 6] = of[8 * c_ + 6] * al_ + p_ * bf_lo(w_.w); of[8 * c_ + 7] = of[8 * c_ + 7] * al_ + p_ * bf_hi(w_.w); }           \
    } while (0)
__device__ __forceinline__ void phase_attn_naive(const Frame& F0, int layer) {
    Frame F = F0; asm volatile("" : "+v"(F.tid)); F.lane = F.tid & 63;
    const bf16* Qb = (const bf16*)(F.ws + WS_BIG); const bf16* Kb = Qb + (size_t)M * D; const bf16* Vb = Kb + (size_t)M * D; bf16* Ob = (bf16*)(F.ws + WS_HB);
    const float* fbase = (const float*)(F.ws + WS_FB); const float* kmb = (const float*)(F.ws + WS_CTL + CTL_KM) + (size_t)layer * 32768;
    const int part = F.tid & 3, ql = F.tid >> 2;
    for (int item = F.blk; item < BATCH * NH * 16; item += F.G) {
        const int bh = item >> 4, qc = item & 15, b = bh >> 4, h = bh & 15, t = qc * 128 + ql;
        const bf16* Qh = Qb + (size_t)bh * SEQ * HD; const bf16* Kh = Kb + (size_t)bh * SEQ * HD + part * 32; const bf16* Vh = Vb + (size_t)bh * SEQ * HD + part * 32;
        float qf[32], of[32]; float mrun = -1.0e30f, lrun = 0.f;
        { const u32x4* qp = (const u32x4*)(Qh + (size_t)t * HD + part * 32);
#pragma unroll
          for (int c = 0; c < 4; ++c) { const u32x4 w = qp[c]; qf[8 * c] = bf_lo(w.x); qf[8 * c + 1] = bf_hi(w.x); qf[8 * c + 2] = bf_lo(w.y); qf[8 * c + 3] = bf_hi(w.y);
              qf[8 * c + 4] = bf_lo(w.z); qf[8 * c + 5] = bf_hi(w.z); qf[8 * c + 6] = bf_lo(w.w); qf[8 * c + 7] = bf_hi(w.w); } }
#pragma unroll
        for (int i = 0; i < 32; ++i) of[i] = 0.f;
        const int tmax = qc * 128 + (F.wave * 16 + 15);
        if (h < 6) {
            for (int br = 0; br < 3; ++br) { const int dl = br == 0 ? 1 : (br == 1 ? 4 : 16);
                for (int j = 0; j <= 128; ++j) { const int s = t - j * dl; const bool ok = s >= 0; const int sr = ok ? s : 0;
                    ATT_STEP(Kh + (size_t)sr * HD, Vh + (size_t)sr * HD, 0.f, ok); } }
        } else if (h < 10) {
            const int cur = t >> 8; const float* km = kmb + (size_t)((b * 4 + (h - 6)) * 8) * 128 + part * 32;
            float g[7];
#pragma unroll
            for (int n = 0; n < 7; ++n) { float s = 0.f; if (n < cur) {
#pragma unroll
                    for (int i = 0; i < 32; ++i) s += qf[i] * km[n * 128 + i]; }
                s += SWZ_XOR(s, 1); s += SWZ_XOR(s, 2); g[n] = s; }
            unsigned mask = 1u << cur;
#pragma unroll
            for (int r = 0; r < 3; ++r) { float best = -3.0e38f; int bi = -1;
#pragma unroll
                for (int n = 0; n < 7; ++n) if (n < cur && !((mask >> n) & 1u) && g[n] > best) { best = g[n]; bi = n; }
                if (bi >= 0) mask |= 1u << bi; }
            for (int s = 0; s <= tmax; ++s) { const bool ok = (s <= t) && ((mask >> (s >> 8)) & 1u);
                ATT_STEP(Kh + (size_t)s * HD, Vh + (size_t)s * HD, 0.f, ok); }
        } else {
            const float* fb = fbase + (size_t)(b * 6 + (h - 10)) * SEQ; const float ft = fb[t];
            for (int s = 0; s <= tmax; ++s) { const bool ok = s <= t;
                ATT_STEP(Kh + (size_t)s * HD, Vh + (size_t)s * HD, fb[s] - ft, ok); }
        }
        const float rl = 1.0f / lrun;
        u32x4* op = (u32x4*)(Ob + (size_t)(b * SEQ + t) * D + h * HD + part * 32);
#pragma unroll
        for (int c = 0; c < 4; ++c) { u32x4 w; w.x = pk2(of[8 * c] * rl, of[8 * c + 1] * rl); w.y = pk2(of[8 * c + 2] * rl, of[8 * c + 3] * rl);
            w.z = pk2(of[8 * c + 4] * rl, of[8 * c + 5] * rl); w.w = pk2(of[8 * c + 6] * rl, of[8 * c + 7] * rl); op[c] = w; }
    }
}
namespace att {
constexpr int D = 128;
constexpr float THR2 = 11.541560327111707f;
constexpr int OPITCH = 2048;
constexpr bool WSKIP = false;
constexpr int NW = 8, QBLK = 32, KVBLK = 64, QB = NW * QBLK;
constexpr int SHM_V = KVBLK * D * 2, SHM_K = KVBLK * D * 2;
constexpr int LUT_N = 2368, LUT_OFF = 68608, KBT_OFF = LUT_OFF + LUT_N * 4, KM_OFF = KBT_OFF + 8192, ZERO_OFF = KM_OFF + 4096, NINF_OFF = ZERO_OFF + 256, ATT_LDS_END = NINF_OFF + 256;
typedef unsigned short bf16;
__device__ __forceinline__ int att_tid() { int t = threadIdx.x; asm volatile("" : "+v"(t)); return t; }
typedef short bf16x8 __attribute__((ext_vector_type(8)));
typedef short s16x4 __attribute__((ext_vector_type(4)));
typedef float f32x16 __attribute__((ext_vector_type(16)));
typedef float f32x4 __attribute__((ext_vector_type(4)));
typedef unsigned u32x4 __attribute__((ext_vector_type(4)));
template <class A, class Bt> struct same_t { static constexpr bool v = false; };
template <class A> struct same_t<A, A> { static constexpr bool v = true; };

#define KSWZ(row, colB) ((row) * 256 + ((colB) ^ (((row) & 7) << 4)))
#define SBAR() __builtin_amdgcn_sched_barrier(0)
__device__ __forceinline__ int v_st(int k, int c) { const int kk = (k & ~0xC) | ((k & 4) << 1) | ((k & 8) >> 1); return ((kk >> 3) * 4 + (c >> 5)) * 512 + ((kk & 7) * 32 + (c & 31)) * 2; }
__device__ __forceinline__ int v_rd_base(int lane) { return ((lane & 3) << 3) | (((lane >> 2) & 3) << 6) | (((lane >> 4) & 1) << 5) | (((lane >> 5) & 1) << 8); }
constexpr int v_rd_off(int d0, int ks, int half) { return d0 * 512 + ks * 4096 + half * 2048; }
__device__ __forceinline__ int crow(int r, int hi) { return (r & 3) + 8 * (r >> 2) + 4 * hi; }
__device__ __forceinline__ unsigned cvtpk(float lo, float hi) {
    unsigned r; asm volatile("v_cvt_pk_bf16_f32 %0, %1, %2" : "=v"(r) : "v"(lo), "v"(hi)); return r;
}
__device__ __forceinline__ bf16x8 pack8(f32x4 a, f32x4 b) {
    u32x4 w = {cvtpk(a[0], a[1]), cvtpk(a[2], a[3]), cvtpk(b[0], b[1]), cvtpk(b[2], b[3])};
    return *reinterpret_cast<bf16x8*>(&w);
}
template <class T> __device__ __forceinline__ bf16x8 load8(const T* p) {
    if constexpr (same_t<T, float>::v) { return pack8(*(const f32x4*)p, *(const f32x4*)(p + 4)); }
    else { return *reinterpret_cast<const bf16x8*>(p); }
}
__device__ __forceinline__ void mask_tile(f32x16& p0, f32x16& p1, int dq, unsigned W) {
    const float NEG = -__builtin_inff();
#pragma unroll
    for (int r = 0; r < 16; ++r) {
        const int c = (r & 3) + 8 * (r >> 2);
        if ((unsigned)(dq - c) >= W) p0[r] = NEG;
        if ((unsigned)(dq - c - 32) >= W) p1[r] = NEG;
    }
}
struct BiasCtx { int mode; unsigned lut, kbt, zero, ninf, qmask; };
__device__ __forceinline__ void bias_tile(f32x16& p0, f32x16& p1, unsigned va) {
#pragma unroll
    for (int g = 0; g < 4; ++g) {
#pragma unroll
        for (int k = 0; k < 4; ++k) { const int r = 4 * g + k, c = (r & 3) + 8 * (r >> 2);
            p0[r] += *(const __attribute__((address_space(3))) float*)(va + 4 * c);
            p1[r] += *(const __attribute__((address_space(3))) float*)(va + 4 * (c + 32)); }
        __builtin_amdgcn_sched_barrier(0); }
}
__device__ __forceinline__ void partialSM(f32x16& p0, f32x16& p1, float& m_reg, float& mn, float& alpha) {
    float pmax = p0[0]; for (int r = 1; r < 16; ++r) pmax = fmaxf(pmax, p0[r]); for (int r = 0; r < 16; ++r) pmax = fmaxf(pmax, p1[r]);
    { auto rr = __builtin_amdgcn_permlane32_swap(__float_as_uint(pmax), __float_as_uint(pmax), false, false);
      pmax = fmaxf(__uint_as_float(rr[0]), __uint_as_float(rr[1])); }
    if (__builtin_expect(__all((pmax - m_reg) <= THR2), 1)) { mn = m_reg; alpha = 1.f; }
    else { mn = fmaxf(m_reg, pmax); alpha = __builtin_amdgcn_exp2f(m_reg - mn); m_reg = mn; }
    for (int r = 0; r < 16; ++r) p0[r] = p0[r] - mn; for (int r = 0; r < 16; ++r) p1[r] = p1[r] - mn;
    for (int r = 0; r < 16; ++r) p0[r] = __builtin_amdgcn_exp2f(p0[r]);
}
__device__ __forceinline__ void finishSM(f32x16& p0, f32x16& p1, float alpha, float& l_reg, bf16x8& pa0, bf16x8& pa1, bf16x8& pa2, bf16x8& pa3) {
    for (int r = 0; r < 16; ++r) p1[r] = __builtin_amdgcn_exp2f(p1[r]);
    float ps = 0; for (int r = 0; r < 16; ++r) ps += p0[r]; for (int r = 0; r < 16; ++r) ps += p1[r];
    { auto rr = __builtin_amdgcn_permlane32_swap(__float_as_uint(ps), __float_as_uint(ps), false, false);
      ps = __uint_as_float(rr[0]) + __uint_as_float(rr[1]); }
    l_reg = l_reg * alpha + ps;
#define PK4(P, B_, OUT) do { unsigned a0 = cvtpk(P[B_+0], P[B_+1]), a1 = cvtpk(P[B_+2], P[B_+3]);                          \
        unsigned b0 = cvtpk(P[B_+4], P[B_+5]), b1 = cvtpk(P[B_+6], P[B_+7]);                                             \
        auto r0 = __builtin_amdgcn_permlane32_swap(a0, b0, false, false); auto r1 = __builtin_amdgcn_permlane32_swap(a1, b1, false, false); \
        u32x4 w = {r0[0], r1[0], r0[1], r1[1]}; OUT = *reinterpret_cast<bf16x8*>(&w); } while (0)
    PK4(p0, 0, pa0); PK4(p0, 8, pa1); PK4(p1, 0, pa2); PK4(p1, 8, pa3);
#undef PK4
}
template <int KB, bool SK>
__device__ __forceinline__ void qkt(f32x16& p0, f32x16& p1, const char* K_lds, int r32, int hi, const bf16x8* qr, bool act) {
    if (SK && !act) { const float NEG = -__builtin_inff();
#pragma unroll
        for (int r = 0; r < 16; ++r) { p0[r] = NEG; p1[r] = NEG; } return; }
    p0 = f32x16{}; p1 = f32x16{};
    const char* kb[4];
#pragma unroll
    for (int dd = 0; dd < 4; ++dd) kb[dd] = K_lds + KB * SHM_K + KSWZ(r32, (dd * 16 + hi * 8) * 2);
#pragma unroll
    for (int d0 = 0; d0 < 8; ++d0) { const char* a = kb[d0 & 3] + (d0 >> 2) * 128;
        bf16x8 b0 = *reinterpret_cast<const bf16x8*>(a);
        bf16x8 b1 = *reinterpret_cast<const bf16x8*>(a + 32 * 256);
        p0 = __builtin_amdgcn_mfma_f32_32x32x16_bf16(b0, qr[d0], p0, 0, 0, 0);
        p1 = __builtin_amdgcn_mfma_f32_32x32x16_bf16(b1, qr[d0], p1, 0, 0, 0); }
}
template <int VB, bool SK>
__device__ __forceinline__ void pv_tile(f32x16* o, int vb0, bf16x8 pa0, bf16x8 pa1, bf16x8 pa2, bf16x8 pa3, bool act) {
    if (SK && !act) return;
#define TRRD(dst, off) asm volatile("ds_read_b64_tr_b16 %0, %1 offset:%2" : "=&v"(dst) : "v"(vb0), "i"(off) : "memory")
#define PV_D0(d0) do { s16x4 l0, l1, l2, l3, h0, h1, h2, h3; constexpr int b_ = VB * SHM_V + v_rd_off(d0, 0, 0);     \
        TRRD(l0, b_); TRRD(h0, b_ + 2048); TRRD(l1, b_ + 4096); TRRD(h1, b_ + 6144); TRRD(l2, b_ + 8192); TRRD(h2, b_ + 10240); TRRD(l3, b_ + 12288); TRRD(h3, b_ + 14336); \
        asm volatile("s_waitcnt lgkmcnt(0)" ::: "memory"); SBAR();                 \
        o[d0] = __builtin_amdgcn_mfma_f32_32x32x16_bf16(pa0, (bf16x8){l0[0], l0[1], l0[2], l0[3], h0[0], h0[1], h0[2], h0[3]}, o[d0], 0, 0, 0);   \
        o[d0] = __builtin_amdgcn_mfma_f32_32x32x16_bf16(pa1, (bf16x8){l1[0], l1[1], l1[2], l1[3], h1[0], h1[1], h1[2], h1[3]}, o[d0], 0, 0, 0);   \
        o[d0] = __builtin_amdgcn_mfma_f32_32x32x16_bf16(pa2, (bf16x8){l2[0], l2[1], l2[2], l2[3], h2[0], h2[1], h2[2], h2[3]}, o[d0], 0, 0, 0);   \
        o[d0] = __builtin_amdgcn_mfma_f32_32x32x16_bf16(pa3, (bf16x8){l3[0], l3[1], l3[2], l3[3], h3[0], h3[1], h3[2], h3[3]}, o[d0], 0, 0, 0); } while (0)
    PV_D0(0); PV_D0(1); PV_D0(2); PV_D0(3);
#undef PV_D0
#undef TRRD
}

template <class TIn, class TOut> struct BlockRef { const TIn* Q; const TIn* K; const TIn* V; TOut* O; int P0; };
template <class TIn> struct Seam {
    bf16x8 qr[8];
    bf16x8 st_v0, st_v1, st_k0, st_k1; f32x4 sf0, sf1, sf2, sf3;
    f32x4 tq[16];
};
__device__ __forceinline__ int swa_jlo(int P0, int W) { const int lowk = P0 - W + 1; return lowk > 0 ? lowk / KVBLK : 0; }
#define ROW(p, k0, rr) ((p) + (size_t)((k0) + (rr)) * D + sc)
#define VMW() asm volatile("s_waitcnt vmcnt(0)" ::: "memory")
#define VMWN(n) asm volatile("s_waitcnt vmcnt(%0)" :: "i"(n) : "memory")
#define SLOAD_H(Kp, Vp, k0) do { S.st_v0 = load8<TIn>(ROW(Vp, k0, sr)); S.st_v1 = load8<TIn>(ROW(Vp, k0, 32 + sr));              \
                         S.st_k0 = load8<TIn>(ROW(Kp, k0, sr)); S.st_k1 = load8<TIn>(ROW(Kp, k0, 32 + sr)); } while (0)
#define SWRITE_HK(bf) do { *(bf16x8*)(K_lds + (bf) * SHM_K + kws) = S.st_k0; *(bf16x8*)(K_lds + (bf) * SHM_K + kws + 32 * 256) = S.st_k1; } while (0)
#define SWRITE_HV(bf) do { *(bf16x8*)(V_lds + (bf) * SHM_V + vst0) = S.st_v0; *(bf16x8*)(V_lds + (bf) * SHM_V + vst1) = S.st_v1; } while (0)
#define SWRITE_H(bf) do { SWRITE_HV(bf); SWRITE_HK(bf); } while (0)
#define SLOAD_F(p, k0) do { S.sf0 = *(const f32x4*)ROW(p, k0, sr); S.sf1 = *(const f32x4*)(ROW(p, k0, sr) + 4);                \
                            S.sf2 = *(const f32x4*)ROW(p, k0, 32 + sr); S.sf3 = *(const f32x4*)(ROW(p, k0, 32 + sr) + 4); } while (0)
#define SWRITE_KF(bf) do { *(bf16x8*)(K_lds + (bf) * SHM_K + kws) = pack8(S.sf0, S.sf1); *(bf16x8*)(K_lds + (bf) * SHM_K + kws + 32 * 256) = pack8(S.sf2, S.sf3); } while (0)
#define SWRITE_VF(bf) do { *(bf16x8*)(V_lds + (bf) * SHM_V + vst0) = pack8(S.sf0, S.sf1); *(bf16x8*)(V_lds + (bf) * SHM_V + vst1) = pack8(S.sf2, S.sf3); } while (0)
template <class TIn, class TOut>
__device__ __forceinline__ void causal_swa_prime(const BlockRef<TIn, TOut>& cur, int W, char* lds, Seam<TIn>& S) {
    constexpr bool F32 = same_t<TIn, float>::v;
    const int tid = att_tid(), wid = __builtin_amdgcn_readfirstlane(tid >> 6), lane = tid & 63, r32 = lane & 31, hi = lane >> 5;
    const int sr = tid >> 4, sc = (tid & 15) * 8, kws = KSWZ(sr, sc * 2); char* K_lds = lds + 2 * SHM_V;
    const int kb0 = swa_jlo(cur.P0, W) * KVBLK;
    for (int d0 = 0; d0 < 8; ++d0) S.qr[d0] = load8<TIn>(cur.Q + (size_t)(wid * QBLK + r32) * D + d0 * 16 + hi * 8);
    if constexpr (F32) { SLOAD_F((const float*)cur.K, kb0); VMW(); SWRITE_KF(0); SBAR(); SLOAD_F((const float*)cur.V, kb0); }
    else { SLOAD_H(cur.K, cur.V, kb0); VMW(); SWRITE_HK(0); }
    __syncthreads();
}
template <class TIn, class TOut>
__device__ __forceinline__ void causal_swa_block(const BlockRef<TIn, TOut>& cur, const BlockRef<TIn, TOut>& nxt, int skv, int W, char* lds, Seam<TIn>& S, const BiasCtx& bc) {
    constexpr bool F32 = same_t<TIn, float>::v;
    const int tid = att_tid(), wid = __builtin_amdgcn_readfirstlane(tid >> 6), lane = tid & 63, r32 = lane & 31, hi = lane >> 5;
    const int j_lo = swa_jlo(cur.P0, W);
    int j_hi = (cur.P0 + QB - 1) / KVBLK + 1; if (j_hi > skv / KVBLK) j_hi = skv / KVBLK;
    const int NT = j_hi - j_lo;
    const int kbn = swa_jlo(nxt.P0, W) * KVBLK;
    const int qlo = cur.P0 + wid * QBLK, qm = qlo + r32 - 4 * hi;
    char* V_lds = lds; char* K_lds = lds + 2 * SHM_V;
    float* ws = (float*)(lds + 2 * SHM_V + 2 * SHM_K) + wid * 64; float* li_l = ws, * al_l = ws + 32;
    float m_reg = -1e30f, l_reg = 0; f32x16 o[4] = {};
    const int sr = tid >> 4, sc = (tid & 15) * 8, vst0 = v_st(sr, sc), vst1 = v_st(32 + sr, sc), kws = KSWZ(sr, sc * 2);
    const int vb0 = (int)(uintptr_t)V_lds + v_rd_base(lane);
    const TIn* Kh = cur.K; const TIn* Vh = cur.V;
#define RESC(a) do { if (__any((a) < 1.f)) { if (hi == 0) al_l[r32] = (a); asm volatile("s_waitcnt lgkmcnt(0)" ::: "memory");              \
                     for (int d_ = 0; d_ < 4; ++d_) for (int r = 0; r < 16; ++r) o[d_][r] *= al_l[crow(r, hi)]; } } while (0)
#define KBASE(t) ((j_lo + (t)) * KVBLK)
#define ACT(t) (KBASE(t) <= qlo + QBLK - 1 && KBASE(t) + KVBLK - 1 >= qlo - W + 1)
#define MASKT(P0_, P1_, t) do { const int kb_ = KBASE(t); unsigned va_;                                                              \
        if (bc.mode == 0) va_ = bc.lut + 4u * (unsigned)(2047 - qm + kb_);                                \
        else if (bc.mode == 1) va_ = ((bc.qmask >> (kb_ >> 8)) & 1u) ? bc.zero : bc.ninf;        \
        else va_ = bc.kbt + 4u * (unsigned)(kb_ + 4 * hi);                                                        \
        bias_tile(P0_, P1_, va_);                                                                                                         \
        if (kb_ + KVBLK - 1 > qlo) mask_tile(P0_, P1_, qm - kb_, 0x7fffffffu); } while (0)
    constexpr int NQL = F32 ? 16 : 8;
    constexpr bool SK = WSKIP && !F32;
#define SEAM_K0() do { VMWN(NQL); if constexpr (F32) { SWRITE_KF(0); SBAR(); SLOAD_F((const float*)nxt.V, kbn); } else { SWRITE_HK(0); } SBAR(); } while (0)
    f32x16 pA0, pA1, pB0, pB1; float mnA, mnB, alA, alB; bf16x8 pa0, pa1, pa2, pa3;
    if constexpr (F32) { VMW(); SWRITE_VF(0); SBAR(); } else { SWRITE_HV(0); SBAR(); }
    if (NT > 1) { if constexpr (F32) SLOAD_F((const float*)Kh, KBASE(1)); else SLOAD_H(Kh, Vh, KBASE(1)); }
    SBAR(); qkt<0, SK>(pA0, pA1, K_lds, r32, hi, S.qr, ACT(0));
    if constexpr (F32) { if (NT > 1) { VMW(); SWRITE_KF(1); SBAR(); SLOAD_F((const float*)Vh, KBASE(1)); } }
    MASKT(pA0, pA1, 0); partialSM(pA0, pA1, m_reg, mnA, alA);
    if (NT > 1) { VMW(); if constexpr (F32) { SWRITE_VF(1); SBAR(); if (NT > 2) SLOAD_F((const float*)Kh, KBASE(2)); } else SWRITE_H(1); }
    __syncthreads();
#define HALF_STEP(PX0, PX1, mnX, alX, PY0, PY1, alY, t, KB, VB, SB) do {                                                      \
        SBAR(); qkt<KB, SK>(PX0, PX1, K_lds, r32, hi, S.qr, ACT(t));                                             \
        finishSM(PY0, PY1, alY, l_reg, pa0, pa1, pa2, pa3); SBAR();                                                           \
        if ((t) + 1 < NT) { if constexpr (F32) { VMW(); SWRITE_KF(SB); SBAR(); SLOAD_F((const float*)Vh, KBASE((t) + 1)); }  \
                            else { SLOAD_H(Kh, Vh, KBASE((t) + 1)); } SBAR(); }                                               \
        pv_tile<VB, SK>(o, vb0, pa0, pa1, pa2, pa3, ACT((t) - 1)); MASKT(PX0, PX1, (t)); partialSM(PX0, PX1, m_reg, mnX, alX);                                        \
        __syncthreads();                                                                                                      \
        if ((t) + 1 < NT) { VMW(); if constexpr (F32) { SWRITE_VF(SB); SBAR(); if ((t) + 2 < NT) SLOAD_F((const float*)Kh, KBASE((t) + 2)); } \
                            else { SWRITE_H(SB); } }                                                                          \
        RESC(alX); __syncthreads(); } while (0)
    for (int t = 1; t + 1 < NT; t += 2) {
        HALF_STEP(pB0, pB1, mnB, alB, pA0, pA1, alA, t, 1, 0, 0);
        HALF_STEP(pA0, pA1, mnA, alA, pB0, pB1, alB, t + 1, 0, 1, 1);
    }
    const bool even = (NT & 1) == 0;
    if (even) { SBAR(); qkt<1, SK>(pB0, pB1, K_lds, r32, hi, S.qr, ACT(NT - 1)); SBAR(); }
#define QROW(e) (nxt.Q + (size_t)(wid * QBLK + r32) * D + ((e) >> 1) * 16 + hi * 8 + ((e) & 1) * 4)
    if constexpr (F32) { SLOAD_F((const float*)nxt.K, kbn); SBAR();
#pragma unroll
        for (int e = 0; e < 8; ++e) S.tq[e] = *(const f32x4*)QROW(e); }
    else { SLOAD_H(nxt.K, nxt.V, kbn); SBAR();
#pragma unroll
        for (int d0 = 0; d0 < 8; ++d0) S.qr[d0] = load8<TIn>(nxt.Q + (size_t)(wid * QBLK + r32) * D + d0 * 16 + hi * 8); }
    SBAR();
    finishSM(pA0, pA1, alA, l_reg, pa0, pa1, pa2, pa3); SBAR();
    if constexpr (F32) {
#pragma unroll
        for (int e = 8; e < 16; ++e) S.tq[e] = *(const f32x4*)QROW(e); SBAR(); }
#undef QROW
    pv_tile<0, SK>(o, vb0, pa0, pa1, pa2, pa3, ACT(even ? NT - 2 : NT - 1));
    if (even) { MASKT(pB0, pB1, NT - 1); partialSM(pB0, pB1, m_reg, mnB, alB); __syncthreads(); RESC(alB);
        finishSM(pB0, pB1, alB, l_reg, pa0, pa1, pa2, pa3); SBAR(); pv_tile<1, SK>(o, vb0, pa0, pa1, pa2, pa3, ACT(NT - 1)); }
    SBAR(); SEAM_K0();
    if (hi == 0) li_l[r32] = l_reg; asm volatile("s_waitcnt lgkmcnt(0)" ::: "memory");
    float rli[16];
#pragma unroll
    for (int r = 0; r < 16; ++r) rli[r] = __builtin_amdgcn_rcpf(li_l[crow(r, hi)]);
    TOut* Ow = cur.O + (size_t)(wid * QBLK) * OPITCH;
#pragma unroll
    for (int r = 0; r < 16; ++r) { const int orow = crow(r, hi);
#pragma unroll
        for (int d0 = 0; d0 < 4; ++d0) { const float v = o[d0][r] * rli[r];
            if constexpr (same_t<TOut, float>::v) { Ow[(size_t)orow * OPITCH + d0 * 32 + r32] = v; }
            else { const float vn = __builtin_bit_cast(float, __builtin_amdgcn_ds_swizzle(__builtin_bit_cast(int, v), (1 << 10) | 0x1F));
                   if ((r32 & 1) == 0) *(unsigned*)(Ow + (size_t)orow * OPITCH + d0 * 32 + r32) = cvtpk(v, vn); } } }
    if constexpr (F32) {
#pragma unroll
        for (int d0 = 0; d0 < 8; ++d0) S.qr[d0] = pack8(S.tq[2 * d0], S.tq[2 * d0 + 1]); }
    __syncthreads();
#undef RESC
#undef KBASE
#undef ACT
#undef MASKT
#undef SEAM_K0
#undef HALF_STEP
}
#undef ROW
#undef VMW
#undef VMWN
#undef SLOAD_H
#undef SWRITE_HK
#undef SWRITE_HV
#undef SWRITE_H
#undef SLOAD_F
#undef SWRITE_KF
#undef SWRITE_VF
__device__ __forceinline__ unsigned moba_mask(const bf16x8* qr, unsigned km_addr, int cur, int hi) {
    float g[7];
#pragma unroll
    for (int n = 0; n < 7; ++n) g[n] = 0.f;
#pragma unroll
    for (int d0 = 0; d0 < 8; ++d0) { float q[8];
#pragma unroll
        for (int e = 0; e < 8; ++e) q[e] = __uint_as_float(((unsigned)(unsigned short)qr[d0][e]) << 16);
#pragma unroll
        for (int n = 0; n < 7; ++n) if (n < cur) { const unsigned a = km_addr + (unsigned)(n * 128 + d0 * 16 + hi * 8) * 4u;
            const f32x4 k0 = *(const __attribute__((address_space(3))) f32x4*)a, k1 = *(const __attribute__((address_space(3))) f32x4*)(a + 16);
            g[n] += (q[0] * k0[0] + q[1] * k0[1]) + (q[2] * k0[2] + q[3] * k0[3]) + (q[4] * k1[0] + q[5] * k1[1]) + (q[6] * k1[2] + q[7] * k1[3]); } }
#pragma unroll
    for (int n = 0; n < 7; ++n) { const auto rr = __builtin_amdgcn_permlane32_swap(__float_as_uint(g[n]), __float_as_uint(g[n]), false, false); g[n] = __uint_as_float(rr[0]) + __uint_as_float(rr[1]); }
    unsigned mask = 1u << cur;
#pragma unroll
    for (int r = 0; r < 3; ++r) { float best = -3.0e38f; int bi = -1;
#pragma unroll
        for (int n = 0; n < 7; ++n) if (n < cur && !((mask >> n) & 1u) && g[n] > best) { best = g[n]; bi = n; }
        if (bi >= 0) mask |= 1u << bi; }
    return mask;
}
__device__ __forceinline__ BlockRef<bf16, bf16> mk_ref(int L, int pass, const bf16* Q, const bf16* K, const bf16* V, bf16* O) {
    const int bh = L >> 2, x = L & 3, qb = pass ? 7 - x : x, b = bh >> 4, h = bh & 15;
    BlockRef<bf16, bf16> r; r.Q = Q + ((size_t)bh * 2048 + (size_t)qb * QB) * D; r.K = K + (size_t)bh * 2048 * D; r.V = V + (size_t)bh * 2048 * D;
    r.O = O + ((size_t)(b * 2048 + qb * QB)) * OPITCH + h * D; r.P0 = qb * QB; return r;
}
__device__ __forceinline__ void attn_phase(char* lds, int tid, int blk, int G, const bf16* Q, const bf16* K, const bf16* V, bf16* O, const float* FB, const float* KMg) {
    const unsigned lbase = (unsigned)(uintptr_t)lds;
    { float* lut = (float*)(lds + LUT_OFF); const float NEG = -__builtin_inff();
      for (int j = tid; j < LUT_N; j += 512) { const int d = 2047 - j; float v = NEG;
          if (d >= 0) { const int m = (d <= 128 ? 1 : 0) + (((d & 3) == 0 && d <= 512) ? 1 : 0) + ((d & 15) == 0 ? 1 : 0); v = m == 0 ? NEG : (m == 1 ? 0.f : (m == 2 ? 1.f : 1.584962500721156f)); }
          lut[j] = v; }
      if (tid < 64) { ((float*)(lds + ZERO_OFF))[tid] = 0.f; ((float*)(lds + NINF_OFF))[tid] = NEG; } }
    __syncthreads();
    const int vcu = (G % 8 == 0) ? (blk % 8) * (G / 8) + blk / 8 : blk;
    constexpr int NITEMS = 8 * 16 * 4;
    int L = vcu; if (L >= NITEMS) return;
    int pass = 0;
    BlockRef<bf16, bf16> cur = mk_ref(L, 0, Q, K, V, O);
    Seam<bf16> S;
    causal_swa_prime<bf16, bf16>(cur, 0x40000000, lds, S);
    for (;;) {
        const bool more_pass = pass == 0, more_item = L + G < NITEMS, last = !more_pass && !more_item;
        int passn = pass + 1, Ln = L;
        if (!more_pass) { passn = 0; Ln = more_item ? L + G : L; }
        const BlockRef<bf16, bf16> nxt = last ? cur : mk_ref(Ln, passn, Q, K, V, O);
        const int bh = L >> 2, b = bh >> 4, h = bh & 15;
        BiasCtx bc; bc.mode = h < 6 ? 0 : (h < 10 ? 1 : 2); bc.lut = lbase + LUT_OFF; bc.kbt = lbase + KBT_OFF; bc.zero = lbase + ZERO_OFF; bc.ninf = lbase + NINF_OFF; bc.qmask = 0u;
        int t2 = tid; asm volatile("" : "+v"(t2));
        if (bc.mode == 2) { const float* fb = FB + (size_t)(b * 6 + (h - 10)) * 2048; if (t2 * 4 < cur.P0 + QB) *(f32x4*)(lds + KBT_OFF + t2 * 16) = *(const f32x4*)(fb + t2 * 4); }
        if (bc.mode == 1) { const float* km = KMg + (size_t)((b * 4 + (h - 6)) * 8) * 128; if (t2 < 256) *(f32x4*)(lds + KM_OFF + t2 * 16) = *(const f32x4*)(km + t2 * 4); }
        if (bc.mode != 0) __syncthreads();
        if (bc.mode == 1) bc.qmask = moba_mask(S.qr, lbase + KM_OFF, cur.P0 >> 8, (t2 & 63) >> 5);
        causal_swa_block<bf16, bf16>(cur, nxt, 2048, 0x40000000, lds, S, bc);
        if (last) break;
        cur = nxt; pass = passn; L = Ln;
    }
}
}

constexpr int NPHASES = 19;
#define IN(k) (lo <= (k) && (k) < hi)
#define SEAM(k) do { if (IN((k) + 1)) { KArgs ap_ = kargs(); XcdBarrier b2_; b2_.bar = (unsigned*)(ap_->ws + WS_CTL) + CW_BAR; b2_.x = xb_xcc_id(); b2_.st = (volatile LAS unsigned*)((LAS unsigned char*)lds_raw + MISC_OFF); xcd_barrier(b2_); } } while (0)
#define PHASE_SETUP() KArgs ap = kargs(); Frame F; F.lds = (LAS unsigned char*)lds_raw; F.tid = threadIdx.x; F.lane = F.tid & 63; F.wave = __builtin_amdgcn_readfirstlane(F.tid >> 6); F.blk = blockIdx.x; F.G = gridDim.x; asm volatile("" : "+s"(F.blk), "+s"(F.G)); F.ws = ap->ws; \
    const float* mod = (const float*)(F.ws + WS_MOD); bf16* HB = (bf16*)(F.ws + WS_HB); bf16* YB = (bf16*)(F.ws + WS_Y); bf16* BIG = (bf16*)(F.ws + WS_BIG); bf16* AS = (bf16*)(F.ws + WS_AS); bf16* YS = AS; (void)mod; (void)HB; (void)YB; (void)BIG; (void)AS; (void)YS

template <int l> __device__ __forceinline__ void layer_phases(unsigned char* lds_raw, const int lo, const int hi) {
        const int p0 = 2 + 8 * l;
        if (IN(p0)) { PHASE_SETUP(); const float* modl = mod + (size_t)l * BATCH * NMOD;
            RowArgs R{}; R.has_post = l; R.moe_y = 0; R.has_pre = 1; R.fg = 1; R.router = 0;
            R.xin = l == 0 ? (const float*)ap->in[0] : ap->out; R.xout = ap->out; R.Y = YB; R.gvec = mod + 5 * D; R.lnpost = (const float*)ap->in[6];
            if (X_BF16 && l == 1) { R.xin16 = (const bf16*)(F.ws + WS_X16); R.xout16 = (bf16*)(F.ws + WS_X16); }
            R.lnpre = (const float*)ap->in[3] + l * D; R.sh = modl; R.sc = modl + D; R.hout = HB;
            R.wfg = (const float*)(F.ws + WS_WFG) + (size_t)l * 6 * D; R.bfg = (const float*)ap->in[10] + l * 6; R.logf = (float*)(F.ws + WS_LOGF);
            phase_rows(F, R); SEAM(p0); }
        if (IN(p0 + 1)) { PHASE_SETUP();
            fgate_scan(F);
            pg8::GSched S; S.init(M / 256, NQKV / 256, D, F.G, F.blk, HB, (const bf16*)(F.ws + WS_WIN) + (size_t)l * NQKV * D, 0);
            pg8::EpiQKV E{BIG, (size_t)M * D, (const float*)(F.ws + WS_ROPE), (float*)(F.ws + WS_CTL + CTL_KM) + (size_t)l * 32768, QSCALE};
            pg8::gemm_phase<pg8::EpiQKV, pg8::GSched, true, true>(F.lds, D, S, E);
            SEAM(p0 + 1); }
        if (IN(p0 + 2)) { PHASE_SETUP();
#if defined(ATTN_NAIVE)
            phase_attn_naive(F, l);
#else
            { int tid_ = F.tid; asm volatile("" : "+v"(tid_));
              att::attn_phase((char*)lds_raw, tid_, F.blk, F.G, BIG, BIG + (size_t)M * D, BIG + (size_t)2 * M * D, HB, (const float*)(F.ws + WS_FB), (const float*)(F.ws + WS_CTL + CTL_KM) + (size_t)l * 32768); }
#endif
            SEAM(p0 + 2); }
        if (IN(p0 + 3)) { PHASE_SETUP();
            pg8::GSched S; S.init(M / 256, D / 256, D, F.G, F.blk, HB, (const bf16*)(F.ws + WS_WOUT) + (size_t)l * D * D, 0);
            pg8::EpiBf16 E{YB, D, 1.0f};
            pg8::gemm_phase<pg8::EpiBf16, pg8::GSched, true, true>(F.lds, D, S, E);
            SEAM(p0 + 3); }
        if (IN(p0 + 4)) { PHASE_SETUP(); const float* modl = mod + (size_t)l * BATCH * NMOD;
            RowArgs R{}; R.has_post = 1; R.moe_y = 0; R.has_pre = 1; R.fg = 0; R.router = l; R.out8 = (l == 0 && (DENSE_F8 & 1)) ? 1 : 0;
            R.xin = l == 0 ? (const float*)ap->in[0] : ap->out; R.xout = ap->out; R.Y = YB; R.gvec = modl + 2 * D; R.lnpost = (const float*)ap->in[4] + l * D;
            if (X_BF16) { R.xout16 = (bf16*)(F.ws + WS_X16); if (l == 1) R.xin16 = (const bf16*)(F.ws + WS_X16); }
            R.lnpre = (const float*)ap->in[5] + l * D; R.sh = modl + 3 * D; R.sc = modl + 4 * D; R.hout = HB;
            R.wrt = (const float*)(F.ws + WS_WRT); R.brt = (const float*)ap->in[16]; R.tope = (int*)(F.ws + WS_TOPE); R.topp_out = (float*)(F.ws + WS_TOPP); R.cnt = (int*)(F.ws + WS_CNT);
            phase_rows(F, R); SEAM(p0 + 4); }
        if (l == 0) {
            if (IN(p0 + 6)) { PHASE_SETUP();
                constexpr int KG = (DENSE_F8 & 1) ? D / 2 : D; constexpr float SG = (DENSE_F8 & 1) ? 1.0f / W8_SCALE_GU : 1.0f;
                pg8::GSched S; S.init(M / 256, 2 * DFF / 256, KG, F.G, F.blk, HB, (const bf16*)(F.ws + WS_WGU), 0);
                if constexpr (DENSE_F8 & 2) { pg8::EpiSwiGLU8 E{(unsigned char*)BIG, DFF, SG}; pg8::gemm_phase<pg8::EpiSwiGLU8, pg8::GSched, true, true, (DENSE_F8 & 1) != 0>(F.lds, KG, S, E); }
                else { pg8::EpiSwiGLU E{BIG, DFF, SG}; pg8::gemm_phase<pg8::EpiSwiGLU, pg8::GSched, true, true, (DENSE_F8 & 1) != 0>(F.lds, KG, S, E); }
                SEAM(p0 + 6); }
            if (IN(p0 + 7)) { PHASE_SETUP();
                constexpr int KD = (DENSE_F8 & 2) ? DFF / 2 : DFF; constexpr float SD = (DENSE_F8 & 2) ? 1.0f / W8_SCALE_D : 1.0f;
                pg8::GSched S; S.init(M / 256, D / 256, KD, F.G, F.blk, BIG, (const bf16*)(F.ws + WS_WD), 0);
                pg8::EpiBf16 E{YB, D, SD};
                pg8::gemm_phase<pg8::EpiBf16, pg8::GSched, true, true, (DENSE_F8 & 2) != 0>(F.lds, KD, S, E);
                SEAM(p0 + 7); }
        } else {
            if (IN(p0 + 5)) { PHASE_SETUP(); phase_scatter(F); SEAM(p0 + 5); }
            if (IN(p0 + 6)) { PHASE_SETUP();
                const int* meta = (const int*)(F.ws + WS_META);
                pg8::GSched S; S.init(meta[8], 2 * DFF / 256, D / 2, F.G, F.blk, AS, (const bf16*)(F.ws + WS_EGU), SZ_EGU8);
                S.ts1 = meta[1]; S.ts2 = meta[2]; S.ts3 = meta[3]; S.ts4 = meta[4]; S.ts5 = meta[5]; S.ts6 = meta[6]; S.ts7 = meta[7];
                pg8::EpiSwiGLU8 E{(unsigned char*)BIG, DFF, 1.0f / W8_SCALE_GU};
                pg8::gemm_phase<pg8::EpiSwiGLU8, pg8::GSched, true, true, true>(F.lds, D / 2, S, E);
                SEAM(p0 + 6); }
            if (IN(p0 + 7)) { PHASE_SETUP();
                const int* meta = (const int*)(F.ws + WS_META);
                const int rs = meta[20], nsp = meta[21];
                { pg8::GSched S; S.init(meta[8] - rs, D / 256, DFF / 2, F.G, F.blk, BIG, (const bf16*)(F.ws + WS_ED), SZ_ED8);
                  S.ts1 = meta[1]; S.ts2 = meta[2]; S.ts3 = meta[3]; S.ts4 = meta[4]; S.ts5 = meta[5]; S.ts6 = meta[6]; S.ts7 = meta[7];
                  pg8::EpiBf16 E{YS, D, 1.0f / W8_SCALE_D};
                  pg8::gemm_phase<pg8::EpiBf16, pg8::GSched, true, true, true>(F.lds, DFF / 2, S, E); }
                if (rs > 0) {
                  pg8::GSchedK S; S.init(rs, (D / 256) * nsp, DFF / 2, F.G, F.blk, BIG, (const bf16*)(F.ws + WS_ED), SZ_ED8);
                  S.ts1 = meta[1]; S.ts2 = meta[2]; S.ts3 = meta[3]; S.ts4 = meta[4]; S.ts5 = meta[5]; S.ts6 = meta[6]; S.ts7 = meta[7]; S.pm0 = meta[8] - rs; S.kbytes = (size_t)(DFF / nsp);
                  pg8::EpiBf16K E{(bf16*)(F.ws + WS_PART), D, 1.0f / W8_SCALE_D, PART_STRIDE};
                  pg8::gemm_phase<pg8::EpiBf16K, pg8::GSchedK, true, true, true>(F.lds, DFF / 2, S, E, (DFF / 128) / nsp); }
                SEAM(p0 + 7); }
        }
    }
__global__ void __launch_bounds__(NTHREADS, 2) fwd_kernel(Args args) {
    extern __shared__ __attribute__((aligned(16))) unsigned char lds_raw[];
    volatile LAS unsigned* MISC = (volatile LAS unsigned*)((LAS unsigned char*)lds_raw + MISC_OFF);
    if (threadIdx.x < 64) MISC[threadIdx.x] = 0u;
    __syncthreads();
    if (MK_N_LAUNCHES == 1) (void)xcd_barrier_post((unsigned*)(args.ws + WS_CTL) + CW_BAR, MISC);
    const int lo = args.ph_lo, hi = args.ph_hi;
    if (IN(0)) { PHASE_SETUP(); phase_prologue_a(F, ap); SEAM(0); }
    if (IN(1)) { PHASE_SETUP(); phase_prologue_b(F, ap); SEAM(1); }

    layer_phases<0>(lds_raw, lo, hi);
    layer_phases<1>(lds_raw, lo, hi);
    if (IN(18)) { PHASE_SETUP();
        RowArgs R{}; R.has_post = 1; R.moe_y = 1; R.has_pre = 0; R.fg = 0; R.router = 0;
        R.xin = ap->out; R.xout = ap->out; R.Y = AS; R.slot = (const int*)(F.ws + WS_SLOT); R.topp = (const float*)(F.ws + WS_TOPP);
        if (X_BF16) R.xin16 = (const bf16*)(F.ws + WS_X16);
        { const int* meta = (const int*)(F.ws + WS_META); R.part = (const bf16*)(F.ws + WS_PART); R.split_base = meta[22]; R.nsplit = meta[21]; }
        R.gvec = mod + (size_t)BATCH * NMOD + 5 * D; R.lnpost = (const float*)ap->in[6] + D;
        phase_rows(F, R); }
#undef IN
#undef SEAM
#undef PHASE_SETUP
}

extern "C" void kernel_launch(void* const* d_in, const int* in_sizes, int n_in, void* d_out, int out_size, void* d_ws, size_t ws_size, hipStream_t stream) {
    static int grid = 0;
    if (grid == 0) {
        if (n_in != 20 || in_sizes[0] != M * D || out_size != M * D || ws_size < WS_END) { fprintf(stderr, "kernel_launch: shape/workspace mismatch (n_in %d, in0 %d, out %d, ws %zu, need %zu)\n", n_in, n_in > 0 ? in_sizes[0] : -1, out_size, ws_size, (size_t)WS_END); grid = -1; return; }
        int dev = 0, cus = 0, per_cu = 0;
        if (hipGetDevice(&dev) != hipSuccess || hipDeviceGetAttribute(&cus, hipDeviceAttributeMultiprocessorCount, dev) != hipSuccess) { grid = -1; return; }
        if (hipFuncSetAttribute((const void*)fwd_kernel, hipFuncAttributeMaxDynamicSharedMemorySize, LDS_BYTES) != hipSuccess) { fprintf(stderr, "kernel_launch: hipFuncSetAttribute failed\n"); grid = -1; return; }
        if (hipOccupancyMaxActiveBlocksPerMultiprocessor(&per_cu, (const void*)fwd_kernel, NTHREADS, LDS_BYTES) != hipSuccess || per_cu < 1) fprintf(stderr, "kernel_launch: occupancy query says %d\n", per_cu);
        (void)hipGetLastError();
        if (cus != 256) { fprintf(stderr, "kernel_launch: built for 256 CUs, device has %d\n", cus); grid = -1; return; }
        grid = cus;
    }
    if (grid < 0) return;
    if (hipMemsetAsync((char*)d_ws + WS_CTL, 0, CTL_ZERO_BYTES, stream) != hipSuccess) return;
    Args a{};
    for (int i = 0; i < 20; ++i) a.in[i] = d_in[i];
    a.out = (float*)d_out; a.ws = (unsigned char*)d_ws;
    if (MK_N_LAUNCHES == 1) { a.ph_lo = 0; a.ph_hi = NPHASES; hipLaunchKernelGGL(fwd_kernel, dim3(grid), dim3(NTHREADS), LDS_BYTES, stream, a); }
    else { for (int p = 0; p < NPHASES; ++p) { if (p == 7) continue; a.ph_lo = p; a.ph_hi = p + 1; hipLaunchKernelGGL(fwd_kernel, dim3(grid), dim3(NTHREADS), LDS_BYTES, stream, a); } }
}
```

```cpp
#include <hip/hip_runtime.h>
#include <cstdio>
#include <cstdint>

#ifndef DENSE_F8
#define DENSE_F8 3
#endif
#ifndef X_BF16
#define X_BF16 1
#endif
#ifndef MK_N_LAUNCHES
#define MK_N_LAUNCHES 1
#endif

namespace pg8 {
#define PG8_LAS __attribute__((address_space(3)))
typedef unsigned short bf16_t;
typedef short bf16x8 __attribute__((ext_vector_type(8)));
typedef float f32x4 __attribute__((ext_vector_type(4)));
typedef unsigned u32x4 __attribute__((ext_vector_type(4)));
typedef int i32x4 __attribute__((ext_vector_type(4)));
typedef int i32x8 __attribute__((ext_vector_type(8)));
constexpr int BM = 256, BK = 64, HALF = 128, HTB = HALF * BK * 2  , STAGE_BYTES = 8 * HTB, NXCD = 8, WGM = 8;

__host__ __device__ __forceinline__ int lds_byte(int r, int c) { const int st = (r >> 4) * 2 + (c >> 5), rr = r & 15, cc = c & 31, ob = rr * 64 + cc * 2; return st * 1024 + (ob ^ (((ob >> 9) & 1) << 5)); }
__host__ __device__ __forceinline__ void stage_rc(int b, int& R, int& C) { const int st = b / 1024, sb = b % 1024, swz = sb ^ (((sb >> 9) & 1) << 5); R = (st >> 1) * 16 + swz / 64; C = (st & 1) * 32 + (swz % 64) / 2; }
__host__ __device__ __forceinline__ int perm32(int rho) { const int n = rho >> 4, i = rho & 15; return 8 * (i >> 2) + 4 * n + (i & 3); }

struct Unit { int pm, pn; };

struct GSched {
    int nM, nN, nwg, G, c; const char* A; const char* Bt; size_t tstepA, tstepB, estep; int ts1, ts2, ts3, ts4, ts5, ts6, ts7;
    __device__ __forceinline__ void init(int nM_, int nN_, int K, int G_, int c_, const void* A_, const void* Bt_, size_t estep_) {
        nM = nM_; nN = nN_; nwg = nM * nN; G = G_; c = c_; A = (const char*)A_; Bt = (const char*)Bt_; tstepA = (size_t)BM * K * 2; tstepB = tstepA; estep = estep_;
        ts1 = ts2 = ts3 = ts4 = ts5 = ts6 = ts7 = 0x7fffffff; }
    __device__ __forceinline__ bool next(int i, Unit& u) const {
        const long L = (long)i * G + c; if (L >= nwg) return false;
        int wgid = (int)L; { const int q = nwg / NXCD, r = nwg % NXCD, xcd = wgid % NXCD, off = wgid / NXCD; wgid = (xcd < r ? xcd * (q + 1) : r * (q + 1) + (xcd - r) * q) + off; }
        const int nig = WGM * nN, gid = wgid / nig, fm = gid * WGM, gsz = (nM - fm) < WGM ? (nM - fm) : WGM;
        u.pm = fm + ((wgid % nig) % gsz); u.pn = (wgid % nig) / gsz; return true;
    }
    __device__ __forceinline__ const char* aptr(const Unit& u) const { return A + (size_t)u.pm * tstepA; }
    __device__ __forceinline__ const char* bptr(const Unit& u) const {
        const int e = (u.pm >= ts1) + (u.pm >= ts2) + (u.pm >= ts3) + (u.pm >= ts4) + (u.pm >= ts5) + (u.pm >= ts6) + (u.pm >= ts7);
        return Bt + (size_t)e * estep + (size_t)u.pn * tstepB; }
    __device__ __forceinline__ void a_ready(const Unit&) const {}
    __device__ __forceinline__ void done(const Unit&) const {}
};

struct GSchedK : GSched {
    int pm0; size_t kbytes;
    __device__ __forceinline__ const char* aptr(const Unit& u) const { return A + (size_t)(pm0 + u.pm) * tstepA + (size_t)(u.pn >> 3) * kbytes; }
    __device__ __forceinline__ const char* bptr(const Unit& u) const { const int t = pm0 + u.pm;
        const int e = (t >= ts1) + (t >= ts2) + (t >= ts3) + (t >= ts4) + (t >= ts5) + (t >= ts6) + (t >= ts7);
        return Bt + (size_t)e * estep + (size_t)(u.pn & 7) * tstepB + (size_t)(u.pn >> 3) * kbytes; }
};
__device__ __forceinline__ unsigned cvt_pk_bf16(float lo, float hi) { unsigned r; asm volatile("v_cvt_pk_bf16_f32 %0, %1, %2" : "=v"(r) : "v"(lo), "v"(hi)); return r; }
typedef unsigned u32x2 __attribute__((ext_vector_type(2)));

struct EpiBf16 {
    static constexpr bool PERM = true, AFTER_DRAIN = false;
    bf16_t* O; int ldc; float scale;
    __device__ __forceinline__ void operator()(const f32x4 (&acc)[2][2][4][2], const Unit& u, int wr, int wc, int fr, int fq) const {
        const int row0 = u.pm * BM + wr * 64 + fr, col0 = u.pn * BM + wc * 32 + 8 * fq;
#pragma unroll
        for (int ai = 0; ai < 2; ++ai)
#pragma unroll
            for (int m = 0; m < 4; ++m) { bf16_t* rowp = O + (size_t)(row0 + ai * HALF + m * 16) * ldc + col0;
#pragma unroll
                for (int bj = 0; bj < 2; ++bj) { const f32x4 v0 = acc[ai][bj][m][0] * scale, v1 = acc[ai][bj][m][1] * scale;
                    u32x4 w; w.x = cvt_pk_bf16(v0[0], v0[1]); w.y = cvt_pk_bf16(v0[2], v0[3]); w.z = cvt_pk_bf16(v1[0], v1[1]); w.w = cvt_pk_bf16(v1[2], v1[3]);
                    *(u32x4*)(rowp + bj * HALF) = w; } }
    }
};
struct EpiBf16K {
    static constexpr bool PERM = true, AFTER_DRAIN = false;
    bf16_t* O; int ldc; float scale; size_t pstride;
    __device__ __forceinline__ void operator()(const f32x4 (&acc)[2][2][4][2], const Unit& u, int wr, int wc, int fr, int fq) const {
        const int row0 = u.pm * BM + wr * 64 + fr, col0 = (u.pn & 7) * BM + wc * 32 + 8 * fq; bf16_t* Ob = O + (size_t)(u.pn >> 3) * pstride;
#pragma unroll
        for (int ai = 0; ai < 2; ++ai)
#pragma unroll
            for (int m = 0; m < 4; ++m) { bf16_t* rowp = Ob + (size_t)(row0 + ai * HALF + m * 16) * ldc + col0;
#pragma unroll
                for (int bj = 0; bj < 2; ++bj) { const f32x4 v0 = acc[ai][bj][m][0] * scale, v1 = acc[ai][bj][m][1] * scale;
                    u32x4 w; w.x = cvt_pk_bf16(v0[0], v0[1]); w.y = cvt_pk_bf16(v0[2], v0[3]); w.z = cvt_pk_bf16(v1[0], v1[1]); w.w = cvt_pk_bf16(v1[2], v1[3]);
                    *(u32x4*)(rowp + bj * HALF) = w; } }
    }
};
__device__ __forceinline__ float silu_mul(float g, float u) { return g * u * __builtin_amdgcn_rcpf(1.0f + __builtin_amdgcn_exp2f(-1.4426950408889634f * g)); }
__device__ __forceinline__ f32x4 silu_mul4(const f32x4 ag, const f32x4 au, const float c1, const float K) {
    const f32x4 t = ag * c1;
    f32x4 e; e[0] = __builtin_amdgcn_exp2f(t[0]); e[1] = __builtin_amdgcn_exp2f(t[1]); e[2] = __builtin_amdgcn_exp2f(t[2]); e[3] = __builtin_amdgcn_exp2f(t[3]);
    const f32x4 d = e * K + K;
    f32x4 r; r[0] = __builtin_amdgcn_rcpf(d[0]); r[1] = __builtin_amdgcn_rcpf(d[1]); r[2] = __builtin_amdgcn_rcpf(d[2]); r[3] = __builtin_amdgcn_rcpf(d[3]);
    return (ag * au) * r;
}
struct EpiSwiGLU {
    static constexpr bool PERM = true, AFTER_DRAIN = false;
    bf16_t* O; int ldc; float scale;
    __device__ __forceinline__ void operator()(const f32x4 (&acc)[2][2][4][2], const Unit& u, int wr, int wc, int fr, int fq) const {
        const int row0 = u.pm * BM + wr * 64 + fr, col0 = u.pn * HALF + wc * 32 + 8 * fq;
#pragma unroll
        for (int ai = 0; ai < 2; ++ai)
#pragma unroll
            for (int m = 0; m < 4; ++m) { bf16_t* rowp = O + (size_t)(row0 + ai * HALF + m * 16) * ldc + col0;
                const f32x4 g0 = acc[ai][0][m][0] * scale, g1 = acc[ai][0][m][1] * scale, u0 = acc[ai][1][m][0] * scale, u1 = acc[ai][1][m][1] * scale;
                u32x4 w; w.x = cvt_pk_bf16(silu_mul(g0[0], u0[0]), silu_mul(g0[1], u0[1])); w.y = cvt_pk_bf16(silu_mul(g0[2], u0[2]), silu_mul(g0[3], u0[3]));
                w.z = cvt_pk_bf16(silu_mul(g1[0], u1[0]), silu_mul(g1[1], u1[1])); w.w = cvt_pk_bf16(silu_mul(g1[2], u1[2]), silu_mul(g1[3], u1[3]));
                *(u32x4*)rowp = w; }
    }
};
__device__ __forceinline__ unsigned pk4_fp8(float a, float b, float c, float d) { unsigned w = 0u; w = __builtin_amdgcn_cvt_pk_fp8_f32(a, b, w, false); w = __builtin_amdgcn_cvt_pk_fp8_f32(c, d, w, true); return w; }
struct EpiSwiGLU8 {
    static constexpr bool PERM = true, AFTER_DRAIN = false;
    unsigned char* O; int ldc; float scale;
    __device__ __forceinline__ void operator()(const f32x4 (&acc)[2][2][4][2], const Unit& u, int wr, int wc, int fr, int fq) const {
        const int row0 = u.pm * BM + wr * 64 + fr, col0 = u.pn * HALF + wc * 32 + 8 * fq;
        const float c1 = -1.4426950408889634f * scale, K = 1.0f / (scale * scale);
#pragma unroll
        for (int ai = 0; ai < 2; ++ai)
#pragma unroll
            for (int m = 0; m < 4; ++m) { unsigned char* rowp = O + (size_t)(row0 + ai * HALF + m * 16) * ldc + col0;
                const f32x4 s0 = silu_mul4(acc[ai][0][m][0], acc[ai][1][m][0], c1, K), s1 = silu_mul4(acc[ai][0][m][1], acc[ai][1][m][1], c1, K);
                u32x2 w; w.x = pk4_fp8(s0[0], s0[1], s0[2], s0[3]); w.y = pk4_fp8(s1[0], s1[1], s1[2], s1[3]);
                *(u32x2*)rowp = w; }
    }
};
struct EpiQKV {
    static constexpr bool PERM = true, AFTER_DRAIN = false;
    bf16_t* QKV; size_t tstride; const float* rope; float* km; float qscale;
    __device__ __forceinline__ void operator()(const f32x4 (&acc)[2][2][4][2], const Unit& u, int wr, int wc, int fr, int fq) const {
        const int which = u.pn >> 3, b = u.pm >> 3, blk = u.pm & 7, s0 = blk * 256, head0 = 2 * (u.pn & 7);
        bf16_t* base = QKV + (size_t)which * tstride;
        const float sc = which == 0 ? qscale : 1.0f;
        const bool rot = (which < 2) && (head0 < 10) && (wc == 0);
        const bool dokm = (which == 1) && (head0 >= 6) && (head0 < 10);
        const bool hi = fq >= 2;
        bf16_t* hb = base + ((size_t)(b * 16 + head0) * 2048 + s0) * 128 + wc * 32 + 8 * fq;
        f32x4 ks[2][2] = {{{0.f, 0.f, 0.f, 0.f}, {0.f, 0.f, 0.f, 0.f}}, {{0.f, 0.f, 0.f, 0.f}, {0.f, 0.f, 0.f, 0.f}}};
        const float* rp0 = rope + (size_t)(b * 2048 + s0 + wr * 64 + fr) * 32 + 8 * (fq & 1);
        f32x4 cn0 = {1.f, 1.f, 1.f, 1.f}, cn1 = cn0, sn0 = {0.f, 0.f, 0.f, 0.f}, sn1 = sn0;
        if (rot) { cn0 = *(const f32x4*)rp0; cn1 = *(const f32x4*)(rp0 + 4); sn0 = *(const f32x4*)(rp0 + 16); sn1 = *(const f32x4*)(rp0 + 20); }
#pragma unroll
        for (int g = 0; g < 8; ++g) { const int ai = g >> 2, m = g & 3, row = ai * HALF + wr * 64 + m * 16 + fr;
            const f32x4 c0 = cn0, c1 = cn1; f32x4 q0 = sn0, q1 = sn1;
            if (rot && g < 7) { const int gn = g + 1; const float* rp = rp0 + (size_t)((gn >> 2) * HALF + (gn & 3) * 16) * 32; cn0 = *(const f32x4*)rp; cn1 = *(const f32x4*)(rp + 4); sn0 = *(const f32x4*)(rp + 16); sn1 = *(const f32x4*)(rp + 20); }
            if (rot) { q0 = hi ? q0 : -q0; q1 = hi ? q1 : -q1; }
#pragma unroll
            for (int bj = 0; bj < 2; ++bj) {
                f32x4 v0 = acc[ai][bj][m][0], v1 = acc[ai][bj][m][1];
                if (rot) {
#pragma unroll
                    for (int k = 0; k < 4; ++k) {
                        { const auto r = __builtin_amdgcn_permlane32_swap(__float_as_uint(v0[k]), __float_as_uint(v0[k]), false, false);
                          const float other = hi ? __uint_as_float(r[0]) : __uint_as_float(r[1]); v0[k] = v0[k] * c0[k] + other * q0[k]; }
                        { const auto r = __builtin_amdgcn_permlane32_swap(__float_as_uint(v1[k]), __float_as_uint(v1[k]), false, false);
                          const float other = hi ? __uint_as_float(r[0]) : __uint_as_float(r[1]); v1[k] = v1[k] * c1[k] + other * q1[k]; } } }
                v0 = v0 * sc; v1 = v1 * sc;
                if (dokm) { ks[bj][0] += v0; ks[bj][1] += v1; }
                u32x4 w; w.x = cvt_pk_bf16(v0[0], v0[1]); w.y = cvt_pk_bf16(v0[2], v0[3]); w.z = cvt_pk_bf16(v1[0], v1[1]); w.w = cvt_pk_bf16(v1[2], v1[3]);
                *(u32x4*)(hb + (size_t)bj * 2048 * 128 + (size_t)row * 128) = w; }
            asm volatile("" ::: "memory");
        }
        if (dokm) {
#define PG8_SX(v, X) __builtin_bit_cast(float, __builtin_amdgcn_ds_swizzle(__builtin_bit_cast(int, (float)(v)), (((X) << 10) | 0x1F)))
#define PG8_RED16(v) do { v += PG8_SX(v, 1); v += PG8_SX(v, 2); v += PG8_SX(v, 4); v += PG8_SX(v, 8); } while (0)
#pragma unroll
            for (int bj = 0; bj < 2; ++bj) {
                float a0 = ks[bj][0][0], a1 = ks[bj][0][1], a2 = ks[bj][0][2], a3 = ks[bj][0][3], c0 = ks[bj][1][0], c1 = ks[bj][1][1], c2 = ks[bj][1][2], c3 = ks[bj][1][3];
                PG8_RED16(a0); PG8_RED16(a1); PG8_RED16(a2); PG8_RED16(a3); PG8_RED16(c0); PG8_RED16(c1); PG8_RED16(c2); PG8_RED16(c3);
                if (fr == 0) { float* kp = km + ((size_t)((b * 4 + (head0 + bj - 6)) * 8 + blk)) * 128 + wc * 32 + 8 * fq;
                    __hip_atomic_fetch_add(kp + 0, a0, __ATOMIC_RELAXED, __HIP_MEMORY_SCOPE_AGENT); __hip_atomic_fetch_add(kp + 1, a1, __ATOMIC_RELAXED, __HIP_MEMORY_SCOPE_AGENT);
                    __hip_atomic_fetch_add(kp + 2, a2, __ATOMIC_RELAXED, __HIP_MEMORY_SCOPE_AGENT); __hip_atomic_fetch_add(kp + 3, a3, __ATOMIC_RELAXED, __HIP_MEMORY_SCOPE_AGENT);
                    __hip_atomic_fetch_add(kp + 4, c0, __ATOMIC_RELAXED, __HIP_MEMORY_SCOPE_AGENT); __hip_atomic_fetch_add(kp + 5, c1, __ATOMIC_RELAXED, __HIP_MEMORY_SCOPE_AGENT);
                    __hip_atomic_fetch_add(kp + 6, c2, __ATOMIC_RELAXED, __HIP_MEMORY_SCOPE_AGENT); __hip_atomic_fetch_add(kp + 7, c3, __ATOMIC_RELAXED, __HIP_MEMORY_SCOPE_AGENT); } }
#undef PG8_RED16
#undef PG8_SX
        }
    }
};

template <class Epi, class Sched, bool ALIGN_EPI = false, bool SP2 = false, bool F8 = false>
__device__ __forceinline__ void gemm_phase(PG8_LAS unsigned char* lds, const int K, const Sched& S, const Epi& E, const int ntiles = 0) {
    int tid_ = threadIdx.x; asm volatile("" : "+v"(tid_));
    const int tid = tid_, wid = __builtin_amdgcn_readfirstlane(tid >> 6), lane = tid & 63, wr = wid >> 2, wc = wid & 3, fr = lane & 15, fq = lane >> 4;
    const int nt = ntiles ? ntiles : K / BK;
    unsigned voffA[2], voffB[2];
#pragma unroll
    for (int i = 0; i < 2; ++i) { int R, C; stage_rc(tid * 16 + i * 8192, R, C); const int Rb = Epi::PERM ? ((R & ~31) + perm32(R & 31)) : R;
        voffA[i] = (unsigned)(R * K + C) * 2u; voffB[i] = (unsigned)(Rb * K + C) * 2u; }
    const size_t kstep = (size_t)(BK * 2);
    const size_t hstep = (size_t)HALF * K * 2;
    const unsigned ldsw = (unsigned)wid * 1024u;
    const int aoff = lds_byte(wr * 64 + fr, fq * 8), boff = lds_byte(wc * 32 + fr, fq * 8);
    PG8_LAS unsigned char* const ldsB = lds + 4 * HTB + boff;
#define PG8_SA(b, h) (((b) * 2 + (h)) * HTB)
#define PG8_SB(b, h) ((4 + (b) * 2 + (h)) * HTB)
#define PG8_STAGE(bufoff, gbase, voff) do { _Pragma("unroll") for (int _i = 0; _i < 2; ++_i) \
        __builtin_amdgcn_global_load_lds((const unsigned*)((const char*)(gbase) + (voff)[_i]), (PG8_LAS unsigned*)(lds + (bufoff) + ldsw + _i * 8192), 16, 0, 0); } while (0)
#define PG8_LD8(off) __builtin_shufflevector(*(const PG8_LAS i32x4*)(lds + (off)), *(const PG8_LAS i32x4*)(lds + (off) + 1024), 0, 1, 2, 3, 4, 5, 6, 7)
#define PG8_LDA(dst, b, h) do { if constexpr (F8) { _Pragma("unroll") for (int m = 0; m < 4; ++m) dst##8[m] = PG8_LD8(PG8_SA(b, h) + aoff + m * 2048); } \
        else { _Pragma("unroll") for (int m = 0; m < 4; ++m) _Pragma("unroll") for (int k = 0; k < 2; ++k) dst[m][k] = *(const PG8_LAS bf16x8*)(lds + PG8_SA(b, h) + aoff + m * 2048 + k * 1024); } } while (0)
#define PG8_LDB(dst, b, h) do { if constexpr (F8) { _Pragma("unroll") for (int n = 0; n < 2; ++n) dst##8[n] = __builtin_shufflevector(*(const PG8_LAS i32x4*)(ldsB + ((b) * 2 + (h)) * HTB + n * 2048), *(const PG8_LAS i32x4*)(ldsB + ((b) * 2 + (h)) * HTB + n * 2048 + 1024), 0, 1, 2, 3, 4, 5, 6, 7); } \
        else { _Pragma("unroll") for (int n = 0; n < 2; ++n) _Pragma("unroll") for (int k = 0; k < 2; ++k) dst[n][k] = *(const PG8_LAS bf16x8*)(lds + PG8_SB(b, h) + boff + n * 2048 + k * 1024); } } while (0)
#define PG8_MMA(ai, bj, At, Bt) do { __builtin_amdgcn_s_setprio(1); \
        if constexpr (F8) { _Pragma("unroll") for (int m = 0; m < 4; ++m) _Pragma("unroll") for (int n = 0; n < 2; ++n) \
            asm volatile("v_mfma_scale_f32_16x16x128_f8f6f4 %0, %1, %2, %0, %3, %3 op_sel_hi:[0,0,0]" : "+v"(acc[ai][bj][m][n]) : "v"(Bt##8[n]), "v"(At##8[m]), "v"(one8)); } \
        else { _Pragma("unroll") for (int m = 0; m < 4; ++m) _Pragma("unroll") for (int n = 0; n < 2; ++n) _Pragma("unroll") for (int k = 0; k < 2; ++k) \
            acc[ai][bj][m][n] = __builtin_amdgcn_mfma_f32_16x16x32_bf16(Bt[n][k], At[m][k], acc[ai][bj][m][n], 0, 0, 0); } \
        __builtin_amdgcn_s_setprio(0); } while (0)
#define PG8_WAIT_V(n) asm volatile("s_waitcnt vmcnt(" #n ")" ::: "memory")
#define PG8_WAIT_L(n) asm volatile("s_waitcnt lgkmcnt(" #n ")" ::: "memory")
#define PG8_BAR __builtin_amdgcn_s_barrier()
#define PG8_SCHED __builtin_amdgcn_sched_barrier(0)
    Unit cur, nxt; int ui = 0;
    if (!S.next(0, cur)) return;
    f32x4 acc[2][2][4][2];
#pragma unroll
    for (int a = 0; a < 2; ++a)
#pragma unroll
        for (int b = 0; b < 2; ++b)
#pragma unroll
            for (int m = 0; m < 4; ++m)
#pragma unroll
                for (int n = 0; n < 2; ++n) acc[a][b][m][n] = (f32x4){0.f, 0.f, 0.f, 0.f};
    const int one8 = 0x7f7f7f7f;
    bf16x8 At[4][2], B0[2][2], B1[2][2]; i32x8 At8[4], B08[2], B18[2];
    const char* cA = S.aptr(cur); const char* cB = S.bptr(cur);
    S.a_ready(cur);
    if constexpr (SP2) {
        PG8_STAGE(PG8_SB(0, 0), cB, voffB); PG8_STAGE(PG8_SB(0, 1), cB + hstep, voffB); PG8_STAGE(PG8_SA(0, 0), cA, voffA); PG8_STAGE(PG8_SA(0, 1), cA + hstep, voffA);
        if (wr == 1) PG8_BAR;
        PG8_WAIT_V(2); PG8_BAR;
        PG8_STAGE(PG8_SB(1, 0), cB + kstep, voffB); PG8_STAGE(PG8_SA(1, 0), cA + kstep, voffA); PG8_STAGE(PG8_SB(1, 1), cB + hstep + kstep, voffB);
        PG8_WAIT_V(6); PG8_BAR;
    } else {
        PG8_STAGE(PG8_SB(0, 0), cB, voffB); PG8_STAGE(PG8_SA(0, 0), cA, voffA); PG8_STAGE(PG8_SB(0, 1), cB + hstep, voffB); PG8_STAGE(PG8_SA(0, 1), cA + hstep, voffA);
        if (wr == 1) PG8_BAR;
        PG8_WAIT_V(4); PG8_BAR;
        PG8_STAGE(PG8_SB(1, 0), cB + kstep, voffB); PG8_STAGE(PG8_SA(1, 0), cA + kstep, voffA); PG8_STAGE(PG8_SB(1, 1), cB + hstep + kstep, voffB);
        PG8_WAIT_V(6); PG8_BAR;
    }
    for (;;) {
        const bool has_next = S.next(ui + 1, nxt);
        const char* nA = has_next ? S.aptr(nxt) : cA; const char* nB = has_next ? S.bptr(nxt) : cB;
        for (int t = 0; t < nt; t += 2) {
            const bool last = (t == nt - 2);
            const char* a1 = cA + (size_t)(t + 1) * kstep;
            const char* a2 = last ? nA : cA + (size_t)(t + 2) * kstep; const char* b2 = last ? nB : cB + (size_t)(t + 2) * kstep;
            const char* a3 = a2 + kstep; const char* b3 = b2 + kstep;
            if (last && has_next) S.a_ready(nxt);
            if constexpr (SP2) {
            PG8_LDB(B0, 0, 0); PG8_LDB(B1, 0, 1); PG8_SCHED; PG8_LDA(At, 0, 0); PG8_STAGE(PG8_SA(1, 1), a1 + hstep, voffA);
            PG8_WAIT_V(8); PG8_WAIT_L(0); PG8_BAR; PG8_MMA(0, 0, At, B0); PG8_MMA(0, 1, At, B1); PG8_BAR; PG8_SCHED;
            PG8_LDA(At, 0, 1); PG8_STAGE(PG8_SB(0, 0), b2, voffB); PG8_STAGE(PG8_SB(0, 1), b2 + hstep, voffB); PG8_STAGE(PG8_SA(0, 0), a2, voffA);
            PG8_WAIT_V(8); PG8_WAIT_L(0); PG8_BAR; PG8_MMA(1, 0, At, B0); PG8_MMA(1, 1, At, B1); PG8_BAR; PG8_SCHED;
            PG8_LDB(B0, 1, 0); PG8_LDB(B1, 1, 1); PG8_SCHED; PG8_LDA(At, 1, 0); PG8_STAGE(PG8_SA(0, 1), a2 + hstep, voffA);
            PG8_WAIT_V(8); PG8_WAIT_L(0); PG8_BAR; PG8_MMA(0, 0, At, B0); PG8_MMA(0, 1, At, B1); PG8_BAR; PG8_SCHED;
            PG8_LDA(At, 1, 1); PG8_STAGE(PG8_SB(1, 0), b3, voffB); PG8_STAGE(PG8_SB(1, 1), b3 + hstep, voffB); PG8_STAGE(PG8_SA(1, 0), a3, voffA);
            PG8_WAIT_V(8); PG8_WAIT_L(0); PG8_BAR; PG8_MMA(1, 0, At, B0); PG8_MMA(1, 1, At, B1); PG8_BAR; PG8_SCHED;
            } else {
            PG8_LDB(B0, 0, 0); PG8_SCHED; PG8_LDA(At, 0, 0); PG8_STAGE(PG8_SA(1, 1), a1 + hstep, voffA);
            PG8_WAIT_L(8); PG8_BAR; PG8_WAIT_L(0); PG8_MMA(0, 0, At, B0); PG8_BAR; PG8_SCHED;
            PG8_LDB(B1, 0, 1); PG8_STAGE(PG8_SB(0, 0), b2, voffB);
            PG8_BAR; PG8_WAIT_L(0); PG8_MMA(0, 1, At, B1); PG8_BAR;
            PG8_LDA(At, 0, 1); PG8_STAGE(PG8_SA(0, 0), a2, voffA);
            PG8_BAR; PG8_WAIT_L(0); PG8_MMA(1, 0, At, B0); PG8_BAR; PG8_SCHED;
            PG8_STAGE(PG8_SB(0, 1), b2 + hstep, voffB);
            PG8_WAIT_V(6); PG8_BAR; PG8_MMA(1, 1, At, B1); PG8_BAR;
            PG8_LDB(B0, 1, 0); PG8_SCHED; PG8_LDA(At, 1, 0); PG8_STAGE(PG8_SA(0, 1), a2 + hstep, voffA);
            PG8_WAIT_L(8); PG8_BAR; PG8_WAIT_L(0); PG8_MMA(0, 0, At, B0); PG8_BAR; PG8_SCHED;
            PG8_LDB(B1, 1, 1); PG8_STAGE(PG8_SB(1, 0), b3, voffB);
            PG8_BAR; PG8_WAIT_L(0); PG8_MMA(0, 1, At, B1); PG8_BAR;
            PG8_LDA(At, 1, 1); PG8_STAGE(PG8_SA(1, 0), a3, voffA);
            PG8_BAR; PG8_WAIT_L(0); PG8_MMA(1, 0, At, B0); PG8_BAR; PG8_SCHED;
            PG8_STAGE(PG8_SB(1, 1), b3 + hstep, voffB);
            PG8_WAIT_V(6); PG8_BAR; PG8_MMA(1, 1, At, B1); PG8_BAR;
            }
        }
        if constexpr (F8) asm volatile("s_nop 15\n\ts_nop 15\n\ts_nop 15" ::: "memory");
        if constexpr (ALIGN_EPI) { if (wr == 0) PG8_BAR; }
        if constexpr (!Epi::AFTER_DRAIN) { E(acc, cur, wr, wc, fr, fq); S.done(cur); }
        if (!has_next) break;
#pragma unroll
        for (int a = 0; a < 2; ++a)
#pragma unroll
            for (int b = 0; b < 2; ++b)
#pragma unroll
                for (int m = 0; m < 4; ++m)
#pragma unroll
                    for (int n = 0; n < 2; ++n) acc[a][b][m][n] = (f32x4){0.f, 0.f, 0.f, 0.f};
        cur = nxt; cA = nA; cB = nB; ++ui;
        if constexpr (ALIGN_EPI) { if (wr == 1) PG8_BAR; }
    }
    PG8_WAIT_V(0);
    if constexpr (!ALIGN_EPI) { if (wr == 0) PG8_BAR; }
    PG8_BAR;
    if constexpr (Epi::AFTER_DRAIN) { E.fused(acc, cur, wr, wc, fr, fq, lds, wid, lane); S.done(cur); }
#undef PG8_SA
#undef PG8_SB
#undef PG8_STAGE
#undef PG8_LDA
#undef PG8_LDB
#undef PG8_MMA
#undef PG8_LD8
#undef PG8_WAIT_V
#undef PG8_WAIT_L
#undef PG8_BAR
#undef PG8_SCHED
}
}

constexpr int BATCH = 8, SEQ = 2048, D = 2048, M = BATCH * SEQ, NH = 16, HD = 128, NQKV = 6144, NIN = 6150, DFF = 7168, NE = 8, NMOD = 6 * D;
constexpr int MAXT = 136;
constexpr float RMS_EPS = 1e-6f;
constexpr float QSCALE = 0.08838834764831845f * 1.4426950408889634f;
constexpr float LOG2E = 1.4426950408889634f;
constexpr int NWAVES = 8, NTHREADS = 512;
constexpr float W8_SCALE_GU = 64.0f, W8_SCALE_D = 128.0f;

constexpr size_t MiB = 1u << 20;
constexpr size_t WS_CTL = 0, CTL_ZERO_BYTES = 2 * MiB;
constexpr int CW_TMO = 0, CW_BAR = 4096;
constexpr size_t CTL_KM = 256 * 1024;
constexpr size_t WS_MODP = 2 * MiB;
constexpr size_t WS_MOD = 14 * MiB;
constexpr size_t WS_ROPE = 15 * MiB;
constexpr size_t WS_LOGF = 17 * MiB, WS_FB = 17 * MiB + 512 * 1024;
constexpr size_t WS_WFG = 18 * MiB, WS_WRT = 18 * MiB + 256 * 1024;
constexpr size_t WS_TOPE = 19 * MiB, WS_TOPP = WS_TOPE + 256 * 1024, WS_SLOT = WS_TOPE + 512 * 1024, WS_CNT = WS_TOPE + 768 * 1024, WS_META = WS_CNT + 16 * 1024;
constexpr size_t WS_WIN = 20 * MiB;
constexpr size_t WS_WOUT = 68 * MiB;
constexpr size_t WS_WGU = 84 * MiB;
constexpr size_t WS_WD = 140 * MiB;
constexpr size_t WS_EGU = 168 * MiB;
constexpr size_t WS_ED = 616 * MiB;
constexpr size_t WS_HB = 840 * MiB;
constexpr size_t WS_Y = 904 * MiB;
constexpr size_t WS_BIG = 968 * MiB;
constexpr size_t WS_AS = 1444 * MiB;
constexpr size_t WS_PART = 1580 * MiB;
constexpr size_t PART_STRIDE = (size_t)16 * 256 * D;
constexpr size_t WS_X16 = 1648 * MiB;
constexpr size_t WS_END = 1712 * MiB;
constexpr size_t SZ_WGU = (size_t)2 * DFF * D * 2, SZ_WD = (size_t)D * DFF * 2;
constexpr size_t SZ_EGU8 = (size_t)2 * DFF * D, SZ_ED8 = (size_t)D * DFF;

constexpr int LDS_BYTES = 155648;
constexpr int MISC_OFF = 135168;
static_assert(MISC_OFF + 4096 <= LDS_BYTES, "LDS map");

#define GAS __attribute__((address_space(1)))
#define LAS __attribute__((address_space(3)))
typedef unsigned short bf16;
typedef float f32x4 __attribute__((ext_vector_type(4)));
typedef unsigned u32x4 __attribute__((ext_vector_type(4)));
typedef unsigned u32x2 __attribute__((ext_vector_type(2)));
#define LDS_WAIT() asm volatile("s_waitcnt lgkmcnt(0)" ::: "memory")
#define VM_WAIT() asm volatile("s_waitcnt vmcnt(0)" ::: "memory")
__device__ __forceinline__ unsigned pk2(float lo, float hi) { return pg8::cvt_pk_bf16(lo, hi); }
__device__ __forceinline__ float bf_lo(unsigned w) { return __uint_as_float(w << 16); }
__device__ __forceinline__ float bf_hi(unsigned w) { return __uint_as_float(w & 0xffff0000u); }
#define SWZ_XOR(v, X) __builtin_bit_cast(float, __builtin_amdgcn_ds_swizzle(__builtin_bit_cast(int, (float)(v)), (((X) << 10) | 0x1F)))
__device__ __forceinline__ float wave_sum(float v) {
    v += SWZ_XOR(v, 1); v += SWZ_XOR(v, 2); v += SWZ_XOR(v, 4); v += SWZ_XOR(v, 8); v += SWZ_XOR(v, 16);
    const auto rr = __builtin_amdgcn_permlane32_swap(__float_as_uint(v), __float_as_uint(v), false, false);
    return __uint_as_float(rr[0]) + __uint_as_float(rr[1]);
}

#define XB_TMO      128
#define XB_XCNT(j)  (256  + 64 * (j))
#define XB_XSUB(j)  (1280 + 64 * (j))
#define XB_XGEN(j)  (2304 + 64 * (j))
#define XB_TOP      3328
#define XB_TOPGEN   3392
#define XCD_BAR_WORDS 3456
#define XB_SPIN_CAP (1u << 22)

__device__ __forceinline__ unsigned xb_ld(unsigned* p)              { return __hip_atomic_load(p, __ATOMIC_RELAXED, __HIP_MEMORY_SCOPE_AGENT); }
__device__ __forceinline__ unsigned xb_add(unsigned* p, unsigned v) { return __hip_atomic_fetch_add(p, v, __ATOMIC_RELAXED, __HIP_MEMORY_SCOPE_AGENT); }
__device__ __forceinline__ unsigned xb_xcc_id() { return (unsigned)__builtin_amdgcn_s_getreg((3 << 11) | 20) & 0xFu; }
#define XB_SPIN(cond, bar) do { unsigned _sp = 0; while (cond) { __builtin_amdgcn_s_sleep(1); \
    if ((++_sp & 255u) == 0u) { if (xb_ld(&(bar)[XB_TMO])) break; if (_sp > XB_SPIN_CAP) { atomicAdd(&(bar)[XB_TMO], 1u); break; } } } } while (0)

struct XcdBarrier {
    unsigned* bar; unsigned x;
    volatile LAS unsigned* st;
};

__device__ __forceinline__ XcdBarrier xcd_barrier_post(unsigned* bar, volatile LAS unsigned* st) {
    XcdBarrier b; b.bar = bar; b.x = xb_xcc_id(); b.st = st;
    if (threadIdx.x == 0) (void)xb_add(&bar[XB_XCNT(b.x)], 1u);
    return b;
}
__device__ __forceinline__ void xcd_barrier_complete(unsigned* bar, unsigned x, unsigned& nloc, unsigned& nx) {
    const unsigned G = gridDim.x * gridDim.y * gridDim.z;
    unsigned sum, cnt, mine, sp = 0u;
    for (;;) {
        sum = 0u; cnt = 0u; mine = 0u;
#pragma unroll
        for (unsigned j = 0; j < 16; ++j) { const unsigned c = xb_ld(&bar[XB_XCNT(j)]); sum += c; cnt += (c > 0u) ? 1u : 0u; mine = (j == x) ? c : mine; }
        if (sum == G) break;
        __builtin_amdgcn_s_sleep(1);
        if ((++sp & 255u) == 0u) { if (xb_ld(&bar[XB_TMO])) break; if (sp > XB_SPIN_CAP) { atomicAdd(&bar[XB_TMO], 1u); break; } }
    }
    nloc = mine > 0u ? mine : 1u; nx = cnt > 0u ? cnt : 1u;
}

__device__ __forceinline__ void xcd_barrier(const XcdBarrier& b) {
    asm volatile("s_waitcnt vmcnt(0)" ::: "memory");
    __syncthreads();
    if (threadIdx.x == 0) {
        unsigned* bar = b.bar;
        __builtin_amdgcn_s_waitcnt(0);
        unsigned nloc = b.st[0], nx = b.st[1];
        if (nloc == 0u) { xcd_barrier_complete(bar, b.x, nloc, nx); b.st[0] = nloc; b.st[1] = nx; }
        const unsigned old = xb_add(&bar[XB_XSUB(b.x)], 1u);
        const unsigned gen = old / nloc;
        if (old + 1u == (gen + 1u) * nloc) {
            __builtin_amdgcn_fence(__ATOMIC_RELEASE, "agent");
            asm volatile("s_waitcnt vmcnt(0)" ::: "memory");
            const unsigned og = xb_add(&bar[XB_TOP], 1u);
            const unsigned tg = og / nx;
            if (og + 1u == (tg + 1u) * nx) xb_add(&bar[XB_TOPGEN], 1u);
            else XB_SPIN(xb_ld(&bar[XB_TOPGEN]) == tg, bar);
            __builtin_amdgcn_fence(__ATOMIC_ACQUIRE, "agent");
            xb_add(&bar[XB_XGEN(b.x)], 1u);
            asm volatile("s_waitcnt vmcnt(0)" ::: "memory");
        } else {
            XB_SPIN(xb_ld(&bar[XB_XGEN(b.x)]) == gen, bar);
            __builtin_amdgcn_fence(__ATOMIC_ACQUIRE, "agent");
            asm volatile("s_waitcnt vmcnt(0)" ::: "memory");
        }
    }
    __syncthreads();
}
struct Args { const void* in[20]; float* out; unsigned char* ws; int ph_lo, ph_hi; };
struct Frame {
    LAS unsigned char* lds; int tid, lane, wave, blk, G;
    unsigned char* ws;
};
typedef const __attribute__((address_space(4))) Args* KArgs;
__device__ __forceinline__ KArgs kargs() { KArgs p = (KArgs)__builtin_amdgcn_kernarg_segment_ptr(); asm volatile("" : "+s"(p)); return p; }

typedef float f32x2 __attribute__((ext_vector_type(2)));
template <int VEC>
__device__ __forceinline__ void tr_item(const float* src, size_t ld, int K, bf16* dst, int k0, int ncol0, int drow0, LAS float* scr, int lane) {
    if constexpr (VEC == 4) {
        const int r = lane >> 4, c4 = (lane & 15) * 4;
        const float* sp = src + (size_t)(k0 + r) * ld + ncol0 + c4;
#pragma unroll
        for (int i = 0; i < 16; ++i) { const f32x4 v = *(const f32x4*)(sp + (size_t)(4 * i) * ld);
            LAS float* s = scr + (4 * i + r) * 65 + c4; s[0] = v[0]; s[1] = v[1]; s[2] = v[2]; s[3] = v[3]; }
    } else {
        const int r = lane >> 5, c2 = (lane & 31) * 2;
        const float* sp = src + (size_t)(k0 + r) * ld + ncol0 + c2;
#pragma unroll
        for (int i = 0; i < 32; ++i) { const f32x2 v = *(const f32x2*)(sp + (size_t)(2 * i) * ld);
            LAS float* s = scr + (2 * i + r) * 65 + c2; s[0] = v[0]; s[1] = v[1]; }
    }
    LDS_WAIT(); asm volatile("" ::: "memory");
    const int c = lane & 7, nn = lane >> 3;
#pragma unroll
    for (int j = 0; j < 8; ++j) { const int n = nn + 8 * j; const LAS float* s = scr + (8 * c) * 65 + n;
        u32x4 o; o.x = pk2(s[0], s[65]); o.y = pk2(s[2 * 65], s[3 * 65]); o.z = pk2(s[4 * 65], s[5 * 65]); o.w = pk2(s[6 * 65], s[7 * 65]);
        *(u32x4*)(dst + (size_t)(drow0 + n) * K + k0 + 8 * c) = o; }
    LDS_WAIT(); asm volatile("" ::: "memory");
}

__device__ __forceinline__ void tr_item8(const float* src, size_t ld, int K, unsigned char* dst, int k0, int ncol0, int drow0, float wscale, LAS float* scr, int lane) {
    { const int r = lane >> 4, c4 = (lane & 15) * 4;
      const float* sp = src + (size_t)(k0 + r) * ld + ncol0 + c4;
#pragma unroll
      for (int i = 0; i < 16; ++i) { const f32x4 v = *(const f32x4*)(sp + (size_t)(4 * i) * ld);
          LAS float* s = scr + (4 * i + r) * 65 + c4; s[0] = v[0] * wscale; s[1] = v[1] * wscale; s[2] = v[2] * wscale; s[3] = v[3] * wscale; } }
    LDS_WAIT(); asm volatile("" ::: "memory");
    const int c = lane & 3, nn = lane >> 2;
#pragma unroll
    for (int j = 0; j < 4; ++j) { const int n = nn + 16 * j; const LAS float* s = scr + (16 * c) * 65 + n;
        u32x4 o; o.x = pg8::pk4_fp8(s[0], s[65], s[2 * 65], s[3 * 65]); o.y = pg8::pk4_fp8(s[4 * 65], s[5 * 65], s[6 * 65], s[7 * 65]);
        o.z = pg8::pk4_fp8(s[8 * 65], s[9 * 65], s[10 * 65], s[11 * 65]); o.w = pg8::pk4_fp8(s[12 * 65], s[13 * 65], s[14 * 65], s[15 * 65]);
        *(u32x4*)(dst + (size_t)(drow0 + n) * K + k0 + 16 * c) = o; }
    LDS_WAIT(); asm volatile("" ::: "memory");
}
__device__ __forceinline__ void sincos_d(double a, float& c, float& s) {
    const double n = __builtin_rint(a * 0.15915494309189535);
    double r = __builtin_fma(-n, 6.283185307179586, a); r = __builtin_fma(-n, 2.4492935982947064e-16, r);
    const double r2 = r * r;
    double sp = -1.0 / 25852016738884976640000.0;
    sp = sp * r2 + 1.0 / 51090942171709440000.0;
    sp = sp * r2 - 1.0 / 121645100408832000.0;
    sp = sp * r2 + 1.0 / 355687428096000.0;
    sp = sp * r2 - 1.0 / 1307674368000.0;
    sp = sp * r2 + 1.0 / 6227020800.0;
    sp = sp * r2 - 1.0 / 39916800.0;
    sp = sp * r2 + 1.0 / 362880.0;
    sp = sp * r2 - 1.0 / 5040.0;
    sp = sp * r2 + 1.0 / 120.0;
    sp = sp * r2 - 1.0 / 6.0;
    sp = sp * r2 + 1.0;
    double cp = 1.0 / 620448401733239439360000.0;
    cp = cp * r2 - 1.0 / 1124000727777607680000.0;
    cp = cp * r2 + 1.0 / 2432902008176640000.0;
    cp = cp * r2 - 1.0 / 6402373705728000.0;
    cp = cp * r2 + 1.0 / 20922789888000.0;
    cp = cp * r2 - 1.0 / 87178291200.0;
    cp = cp * r2 + 1.0 / 479001600.0;
    cp = cp * r2 - 1.0 / 3628800.0;
    cp = cp * r2 + 1.0 / 40320.0;
    cp = cp * r2 - 1.0 / 720.0;
    cp = cp * r2 + 1.0 / 24.0;
    cp = cp * r2 - 0.5;
    cp = cp * r2 + 1.0;
    c = (float)cp; s = (float)(sp * r);
}
__device__ __forceinline__ double inv_freq_d(int i) {
    const double t[16] = {1.0, 0.44036660267178046, 0.19392274474868576, 0.08539710028576561, 0.03760603093086393, 0.016560440080994446, 0.007292664737217109, 0.003211445994752591,
                          0.001414213562373095, 0.000622772421914596, 0.0002742481756762073, 0.00012076973741146504, 5.318295896944988e-05, 2.341999896140934e-05, 1.031338537721246e-05, 4.5416704806078695e-06};
    double v = t[0];
#pragma unroll
    for (int k = 1; k < 16; ++k) v = (i == k) ? t[k] : v;
    return v;
}


typedef float f32x4u __attribute__((ext_vector_type(4), aligned(8)));
struct ConvStep { const float* src; size_t ld; unsigned char* dst; int kdst, k0, ncol0, drow0, out8; float wscale; };
__device__ __forceinline__ ConvStep conv_decode(KArgs ap, unsigned char* ws, int item, int sub, int wave) {
    ConvStep c; int r = item;
    if (r < 27 * 112) {
        const int mat = r / 112, q = r % 112, set = mat / 3, kind = mat % 3;
        if (kind < 2) { const int strip = q >> 3, kc = q & 7; c.ncol0 = strip * 512 + wave * 64; c.k0 = (kc * 4 + sub) * 64; c.ld = DFF;
            c.src = set == 0 ? (const float*)ap->in[12 + kind] : (const float*)ap->in[17 + kind] + (size_t)(set - 1) * D * DFF;
            c.out8 = set == 0 ? ((DENSE_F8 & 1) ? 1 : 0) : 1; c.wscale = W8_SCALE_GU; c.kdst = c.out8 ? D : 2 * D;
            c.dst = set == 0 ? ws + WS_WGU : ws + WS_EGU + (size_t)(set - 1) * SZ_EGU8; c.drow0 = 256 * (c.ncol0 >> 7) + (c.ncol0 & 127) + kind * 128; }
        else { const int strip = q / 28, kc = q % 28; c.ncol0 = strip * 512 + wave * 64; c.k0 = (kc * 4 + sub) * 64; c.ld = D;
            c.src = set == 0 ? (const float*)ap->in[14] : (const float*)ap->in[19] + (size_t)(set - 1) * DFF * D;
            c.out8 = set == 0 ? ((DENSE_F8 & 2) ? 1 : 0) : 1; c.wscale = W8_SCALE_D; c.kdst = c.out8 ? DFF : 2 * DFF;
            c.dst = set == 0 ? ws + WS_WD : ws + WS_ED + (size_t)(set - 1) * SZ_ED8; c.drow0 = c.ncol0; }
        return c; }
    r -= 27 * 112;
    if (r < 64) { const int l = r >> 5, q = r & 31, strip = q >> 3, kc = q & 7; c.ncol0 = strip * 512 + wave * 64; c.k0 = (kc * 4 + sub) * 64; c.ld = D;
        c.src = (const float*)ap->in[11] + (size_t)l * D * D; c.out8 = 0; c.wscale = 1.f; c.kdst = 2 * D; c.dst = ws + WS_WOUT + (size_t)l * D * D * 2; c.drow0 = c.ncol0; return c; }
    r -= 64;
    { const int l = r / 96, q = r % 96, strip = q >> 3, kc = q & 7; c.ncol0 = strip * 512 + wave * 64; c.k0 = (kc * 4 + sub) * 64; c.ld = NIN;
      c.src = (const float*)ap->in[9] + (size_t)l * D * NIN; c.out8 = 0; c.wscale = 1.f; c.kdst = 2 * D; c.dst = ws + WS_WIN + (size_t)l * NQKV * D * 2; c.drow0 = c.ncol0; return c; }
}
constexpr int CONV_ITEMS = 27 * 112 + 64 + 192;
#define CONV_LOAD(buf, cs) do { const float* sp_ = (cs).src + (size_t)((cs).k0 + 4 * gl_) * (cs).ld + (cs).ncol0 + 4 * c_;                                           \
        _Pragma("unroll") for (int p_ = 0; p_ < 4; ++p_) _Pragma("unroll") for (int q_ = 0; q_ < 4; ++q_)                                                       \
            buf[4 * p_ + q_] = *(const f32x4u*)(sp_ + (size_t)(16 * p_ + q_) * (cs).ld); } while (0)
#define CONV_PROC(buf, cs) do {                                                                                                                                  \
        if ((cs).out8) { const float sc_ = (cs).wscale; const int hf_ = ((cs).k0 >> 6) & 1;        \
            _Pragma("unroll") for (int p_ = 0; p_ < 4; ++p_) _Pragma("unroll") for (int e_ = 0; e_ < 4; ++e_)                                                   \
                T[(4 * c_ + e_) * 33 + 16 * hf_ + 4 * p_ + gl_] = pg8::pk4_fp8(buf[4 * p_][e_] * sc_, buf[4 * p_ + 1][e_] * sc_, buf[4 * p_ + 2][e_] * sc_, buf[4 * p_ + 3][e_] * sc_);   \
            LDS_WAIT(); asm volatile("" ::: "memory");                                                                                                           \
            if (hf_) {                                                                                                                                           \
            _Pragma("unroll") for (int i_ = 0; i_ < 8; ++i_) { const int n_ = 8 * i_ + (lane >> 3), pt_ = lane & 7;         \
                u32x4 o_; o_.x = T[n_ * 33 + 4 * pt_]; o_.y = T[n_ * 33 + 4 * pt_ + 1]; o_.z = T[n_ * 33 + 4 * pt_ + 2]; o_.w = T[n_ * 33 + 4 * pt_ + 3];                                 \
                *(u32x4*)((cs).dst + (size_t)((cs).drow0 + n_) * (cs).kdst + ((cs).k0 - 64) + 16 * pt_) = o_; } }                                                  \
        } else {                                                                                                                                                 \
            _Pragma("unroll") for (int p_ = 0; p_ < 4; ++p_) _Pragma("unroll") for (int e_ = 0; e_ < 4; ++e_) {                                                 \
                T[(4 * c_ + e_) * 33 + 8 * p_ + 2 * gl_] = pk2(buf[4 * p_][e_], buf[4 * p_ + 1][e_]); T[(4 * c_ + e_) * 33 + 8 * p_ + 2 * gl_ + 1] = pk2(buf[4 * p_ + 2][e_], buf[4 * p_ + 3][e_]); } \
            LDS_WAIT(); asm volatile("" ::: "memory");                                                                                                           \
            _Pragma("unroll") for (int i_ = 0; i_ < 8; ++i_) { const int n_ = 8 * i_ + (lane >> 3), pt_ = lane & 7;         \
                u32x4 o_; o_.x = T[n_ * 33 + 4 * pt_]; o_.y = T[n_ * 33 + 4 * pt_ + 1]; o_.z = T[n_ * 33 + 4 * pt_ + 2]; o_.w = T[n_ * 33 + 4 * pt_ + 3];                                 \
                *(u32x4*)((cs).dst + (size_t)((cs).drow0 + n_) * (cs).kdst + (cs).k0 * 2 + 16 * pt_) = o_; }                                                      \
        }                                                                                                                                                        \
        LDS_WAIT(); asm volatile("" ::: "memory"); } while (0)
__device__ __forceinline__ void conv_all(const Frame& F, KArgs ap) {
    LAS unsigned* T = (LAS unsigned*)(F.lds + F.wave * 8448);
    const int lane = F.lane, c_ = lane & 15, gl_ = lane >> 4;
    int nit = 0; for (int it = F.blk; it < CONV_ITEMS; it += F.G) ++nit;
    const int nsteps = nit * 4; if (nsteps == 0) return;
    f32x4 A[16], B[16];
    ConvStep ca = conv_decode(ap, F.ws, F.blk, 0, F.wave), cb = ca;
    CONV_LOAD(A, ca);
    for (int u = 0; u < nsteps; u += 2) {
        { const int un = u + 1; cb = conv_decode(ap, F.ws, F.blk + (un >> 2) * F.G, un & 3, F.wave); CONV_LOAD(B, cb); }
        CONV_PROC(A, ca);
        if (u + 2 < nsteps) { const int un = u + 2; ca = conv_decode(ap, F.ws, F.blk + (un >> 2) * F.G, un & 3, F.wave); CONV_LOAD(A, ca); }
        CONV_PROC(B, cb);
    }
}
#undef CONV_LOAD
#undef CONV_PROC

__device__ __forceinline__ void phase_prologue_a(const Frame& F0, KArgs ap) {
    Frame F = F0; asm volatile("" : "+v"(F.tid)); F.lane = F.tid & 63;
    const float* c_in = (const float*)ap->in[1]; const int* pos = (const int*)ap->in[2];
    const float* w_mod = (const float*)ap->in[7]; const float* w_in = (const float*)ap->in[9]; const float* w_out = (const float*)ap->in[11];
    const float* w_router = (const float*)ap->in[15];
    const int gw = F.blk * NWAVES + F.wave, NGW = F.G * NWAVES, gt = F.blk * NTHREADS + F.tid, NGT = F.G * NTHREADS;
    LAS float* condL = (LAS float*)(F.lds + 69632);
    { float cv[BATCH * D / NTHREADS];
#pragma unroll
      for (int j = 0; j < BATCH * D / NTHREADS; ++j) cv[j] = c_in[F.tid + j * NTHREADS];
#pragma unroll
      for (int j = 0; j < BATCH * D / NTHREADS; ++j) { const int i = F.tid + j * NTHREADS, b = i >> 11, k = i & 2047; const float v = cv[j]; condL[k * 8 + b] = v / (1.0f + __expf(-v)); } }
    __syncthreads();
    for (int it = gw; it < 2 * 48 * 16; it += NGW) {
        const int l = it / 768, r = it % 768, cg = r >> 4, kc = r & 15, col4 = cg * 256 + F.lane * 4;
        f32x4 acc[8];
#pragma unroll
        for (int b = 0; b < 8; ++b) acc[b] = (f32x4){0.f, 0.f, 0.f, 0.f};
        const float* wp = w_mod + ((size_t)l * D + kc * 128) * NMOD + col4;
#pragma unroll 8
        for (int k = 0; k < 128; ++k) { const f32x4 w = *(const f32x4*)(wp + (size_t)k * NMOD); const LAS f32x4* cp = (const LAS f32x4*)(condL + (kc * 128 + k) * 8); const f32x4 c0 = cp[0], c1 = cp[1];
            acc[0] += w * c0[0]; acc[1] += w * c0[1]; acc[2] += w * c0[2]; acc[3] += w * c0[3]; acc[4] += w * c1[0]; acc[5] += w * c1[1]; acc[6] += w * c1[2]; acc[7] += w * c1[3]; }
        float* mp = (float*)(F.ws + WS_MODP) + ((size_t)(kc * 2 + l) * 8) * NMOD + col4;
#pragma unroll
        for (int b = 0; b < 8; ++b) *(f32x4*)(mp + (size_t)b * NMOD) = acc[b];
    }
    { float* rope = (float*)(F.ws + WS_ROPE);
      for (int i = gt; i < M * 16; i += NGT) { const int tok = i >> 4, j = i & 15; float cs, sn; sincos_d((double)pos[tok] * inv_freq_d(j), cs, sn); rope[tok * 32 + j] = cs; rope[tok * 32 + 16 + j] = sn; }
      float* wfg = (float*)(F.ws + WS_WFG);
      for (int i = gt; i < 2 * 6 * D; i += NGT) { const int l = i / (6 * D), r = i % (6 * D), q = r >> 11, k = r & 2047; wfg[i] = w_in[((size_t)l * D + k) * NIN + NQKV + q]; }
      float* wrt = (float*)(F.ws + WS_WRT);
      for (int i = gt; i < NE * D; i += NGT) { const int e = i >> 11, k = i & 2047; wrt[i] = w_router[k * NE + e]; } }
    conv_all(F, ap);
    __syncthreads();
}
__device__ __forceinline__ void phase_prologue_b(const Frame& F0, KArgs ap) {
    Frame F = F0; asm volatile("" : "+v"(F.tid)); F.lane = F.tid & 63;
    const float* b_mod = (const float*)ap->in[8]; const float* mp = (const float*)(F.ws + WS_MODP); float* mod = (float*)(F.ws + WS_MOD);
    for (int i = F.blk * NTHREADS + F.tid; i < 2 * BATCH * NMOD; i += F.G * NTHREADS) { const int l = i / (BATCH * NMOD), r = i % (BATCH * NMOD), col = r % NMOD;
        float s = b_mod[l * NMOD + col];
#pragma unroll
        for (int kc = 0; kc < 16; ++kc) s += mp[(size_t)(kc * 2 + l) * (BATCH * NMOD) + r];
        mod[i] = s; }
}
struct RowArgs {
    int has_post, moe_y, has_pre, fg, router, out8;
    const float* xin; float* xout; const bf16* Y; const int* slot; const float* topp; const float* gvec; const float* lnpost;
    const float* lnpre; const float* sh; const float* sc; bf16* hout;
    const float* wfg; const float* bfg; float* logf;
    const float* wrt; const float* brt; int* tope; float* topp_out; int* cnt;
    const bf16* part; int split_base, nsplit;
    const bf16* xin16; bf16* xout16;
};
__device__ __forceinline__ void phase_rows(const Frame& F0, const RowArgs& R) {
    Frame F = F0; asm volatile("" : "+v"(F.tid)); F.lane = F.tid & 63;
    LAS float* VL = (LAS float*)F.lds;
    LAS int* hist = (LAS int*)(F.lds + MISC_OFF + 64);
    const int b = (F.blk * 64) >> 11;
    { const int t = F.tid;
      if (R.has_post) { ((LAS f32x4*)VL)[t] = ((const f32x4*)(R.gvec + (size_t)b * NMOD))[t]; ((LAS f32x4*)(VL + 2048))[t] = ((const f32x4*)R.lnpost)[t]; }
      if (R.has_pre) { ((LAS f32x4*)(VL + 4096))[t] = ((const f32x4*)R.lnpre)[t]; ((LAS f32x4*)(VL + 6144))[t] = ((const f32x4*)(R.sc + (size_t)b * NMOD))[t] + 1.0f; ((LAS f32x4*)(VL + 8192))[t] = ((const f32x4*)(R.sh + (size_t)b * NMOD))[t]; }
      if (R.fg) {
#pragma unroll
          for (int q = 0; q < 6; ++q) ((LAS f32x4*)(VL + 10240 + q * 2048))[t] = ((const f32x4*)(R.wfg + (size_t)q * D))[t]; }
      if (R.router) {
#pragma unroll
          for (int e = 0; e < 8; ++e) ((LAS f32x4*)(VL + 10240 + e * 2048))[t] = ((const f32x4*)(R.wrt + (size_t)e * D))[t];
          if (t < 8) hist[t] = 0; } }
    __syncthreads();
    for (int ip = 0; ip < 4; ++ip) {
        int lane = F.lane; asm volatile("" : "+v"(lane));
        const int row0 = F.blk * 64 + F.wave * 8 + 2 * ip;
        const LAS f32x4* VV = (const LAS f32x4*)VL + lane;
        f32x4 v[2][8];
        if (R.has_post) {
            f32x4 y[2][8]; float ss[2];
#pragma unroll
            for (int r = 0; r < 2; ++r) { const int row = row0 + r;
                if (!R.moe_y) { const u32x2* yr = (const u32x2*)(R.Y + (size_t)row * D) + lane;
#pragma unroll
                    for (int j = 0; j < 8; ++j) { const u32x2 w = yr[64 * j]; y[r][j] = (f32x4){bf_lo(w.x), bf_hi(w.x), bf_lo(w.y), bf_hi(w.y)}; } }
                else { const int s1 = R.slot[2 * row], s2 = R.slot[2 * row + 1]; const float p1 = R.topp[2 * row], p2 = R.topp[2 * row + 1];
#pragma unroll
                    for (int j = 0; j < 8; ++j) y[r][j] = (f32x4){0.f, 0.f, 0.f, 0.f};
#pragma unroll
                    for (int q = 0; q < 2; ++q) { const int sq = q ? s2 : s1; const float pq = q ? p2 : p1;
                        if (sq < R.split_base) { const u32x2* yq = (const u32x2*)(R.Y + (size_t)sq * D) + lane;
#pragma unroll
                            for (int j = 0; j < 8; ++j) { const u32x2 w = yq[64 * j]; y[r][j] += (f32x4){bf_lo(w.x), bf_hi(w.x), bf_lo(w.y), bf_hi(w.y)} * pq; } }
                        else { for (int ks = 0; ks < R.nsplit; ++ks) { const u32x2* yq = (const u32x2*)(R.part + (size_t)ks * PART_STRIDE + (size_t)(sq - R.split_base) * D) + lane;
#pragma unroll
                            for (int j = 0; j < 8; ++j) { const u32x2 w = yq[64 * j]; y[r][j] += (f32x4){bf_lo(w.x), bf_hi(w.x), bf_lo(w.y), bf_hi(w.y)} * pq; } } } } }
                if (R.xin16) { const u32x2* xr = (const u32x2*)(R.xin16 + (size_t)row * D) + lane;
#pragma unroll
                    for (int j = 0; j < 8; ++j) { const u32x2 w = xr[64 * j]; v[r][j] = (f32x4){bf_lo(w.x), bf_hi(w.x), bf_lo(w.y), bf_hi(w.y)}; } }
                else { const f32x4* xr = (const f32x4*)(R.xin + (size_t)row * D) + lane;
#pragma unroll
                    for (int j = 0; j < 8; ++j) v[r][j] = xr[64 * j]; } }
            asm volatile("" ::: "memory");
#pragma unroll
            for (int r = 0; r < 2; ++r) { float s = 0.f;
#pragma unroll
                for (int j = 0; j < 8; ++j) s += (y[r][j][0] * y[r][j][0] + y[r][j][1] * y[r][j][1]) + (y[r][j][2] * y[r][j][2] + y[r][j][3] * y[r][j][3]);
                ss[r] = s; }
            const float rs0 = 1.0f / sqrtf(wave_sum(ss[0]) * (1.0f / D) + RMS_EPS), rs1 = 1.0f / sqrtf(wave_sum(ss[1]) * (1.0f / D) + RMS_EPS);
            asm volatile("" ::: "memory");
#pragma unroll
            for (int j = 0; j < 8; ++j) { const f32x4 g = VV[64 * j], lp = VV[512 + 64 * j];
                v[0][j] = v[0][j] + g * ((y[0][j] * rs0) * lp); v[1][j] = v[1][j] + g * ((y[1][j] * rs1) * lp); }
#pragma unroll
            for (int r = 0; r < 2; ++r) {
                if (R.xout16) { u32x2* xo = (u32x2*)(R.xout16 + (size_t)(row0 + r) * D) + lane;
#pragma unroll
                    for (int j = 0; j < 8; ++j) { u32x2 w; w.x = pk2(v[r][j][0], v[r][j][1]); w.y = pk2(v[r][j][2], v[r][j][3]); xo[64 * j] = w;
                        v[r][j] = (f32x4){bf_lo(w.x), bf_hi(w.x), bf_lo(w.y), bf_hi(w.y)}; } }
                else { f32x4* xo = (f32x4*)(R.xout + (size_t)(row0 + r) * D) + lane;
#pragma unroll
                    for (int j = 0; j < 8; ++j) xo[64 * j] = v[r][j]; } }
        } else {
#pragma unroll
            for (int r = 0; r < 2; ++r) { const f32x4* xr = (const f32x4*)(R.xin + (size_t)(row0 + r) * D) + lane;
#pragma unroll
                for (int j = 0; j < 8; ++j) v[r][j] = xr[64 * j]; } }
        if (R.has_pre) {
            float ss[2];
#pragma unroll
            for (int r = 0; r < 2; ++r) { float s = 0.f;
#pragma unroll
                for (int j = 0; j < 8; ++j) s += (v[r][j][0] * v[r][j][0] + v[r][j][1] * v[r][j][1]) + (v[r][j][2] * v[r][j][2] + v[r][j][3] * v[r][j][3]);
                ss[r] = s; }
            const float rs0 = 1.0f / sqrtf(wave_sum(ss[0]) * (1.0f / D) + RMS_EPS), rs1 = 1.0f / sqrtf(wave_sum(ss[1]) * (1.0f / D) + RMS_EPS);
            asm volatile("" ::: "memory");
#pragma unroll
            for (int j = 0; j < 8; ++j) { const f32x4 lr = VV[1024 + 64 * j], s1p = VV[1536 + 64 * j], sh = VV[2048 + 64 * j];
                v[0][j] = ((v[0][j] * rs0) * lr) * s1p + sh; v[1][j] = ((v[1][j] * rs1) * lr) * s1p + sh; }
#pragma unroll
            for (int r = 0; r < 2; ++r) { const int row = row0 + r;
#pragma unroll
                for (int j = 0; j < 8; ++j) {
                    if (R.out8) { ((unsigned*)((unsigned char*)R.hout + (size_t)row * D) + lane)[64 * j] = pg8::pk4_fp8(v[r][j][0], v[r][j][1], v[r][j][2], v[r][j][3]); }
                    else { u32x2 w; w.x = pk2(v[r][j][0], v[r][j][1]); w.y = pk2(v[r][j][2], v[r][j][3]); ((u32x2*)(R.hout + (size_t)row * D) + lane)[64 * j] = w; } } }
            if (R.fg) {
                float d0[6], d1[6];
#pragma unroll
                for (int q = 0; q < 6; ++q) { float s0 = 0.f, s1 = 0.f;
#pragma unroll
                    for (int j = 0; j < 8; ++j) { const f32x4 w = VV[2560 + q * 512 + 64 * j];
                        s0 += (v[0][j][0] * w[0] + v[0][j][1] * w[1]) + (v[0][j][2] * w[2] + v[0][j][3] * w[3]); s1 += (v[1][j][0] * w[0] + v[1][j][1] * w[1]) + (v[1][j][2] * w[2] + v[1][j][3] * w[3]); }
                    d0[q] = wave_sum(s0); d1[q] = wave_sum(s1); }
                if (lane < 12) { const int q = lane < 6 ? lane : lane - 6; float z = 0.f;
#pragma unroll
                    for (int k = 0; k < 6; ++k) { z = (lane == k) ? d0[k] : z; z = (lane == k + 6) ? d1[k] : z; }
                    z += R.bfg[q];
                    const float lf = fminf(z, 0.f) - log1pf(__expf(-fabsf(z)));
                    R.logf[((size_t)b * 6 + q) * SEQ + ((row0 + (lane < 6 ? 0 : 1)) & 2047)] = lf; }
            }
            if (R.router) {
#pragma unroll
                for (int r = 0; r < 2; ++r) { const int row = row0 + r;
                    float lg[8];
#pragma unroll
                    for (int e = 0; e < 8; ++e) { float s = 0.f;
#pragma unroll
                        for (int j = 0; j < 8; ++j) { const f32x4 w = VV[2560 + e * 512 + 64 * j]; s += (v[r][j][0] * w[0] + v[r][j][1] * w[1]) + (v[r][j][2] * w[2] + v[r][j][3] * w[3]); }
                        lg[e] = wave_sum(s) + R.brt[e]; }
                    int e1 = 0; float v1 = lg[0];
#pragma unroll
                    for (int e = 1; e < 8; ++e) if (lg[e] > v1) { v1 = lg[e]; e1 = e; }
                    int e2 = -1; float v2 = -3.0e38f;
#pragma unroll
                    for (int e = 0; e < 8; ++e) if (e != e1 && lg[e] > v2) { v2 = lg[e]; e2 = e; }
                    if (lane == 0) { const float p1 = 1.0f / (1.0f + __expf(v2 - v1)); R.tope[2 * row] = e1; R.tope[2 * row + 1] = e2; R.topp_out[2 * row] = p1; R.topp_out[2 * row + 1] = 1.0f - p1;
                        atomicAdd((int*)&hist[e1], 1); atomicAdd((int*)&hist[e2], 1); } }
            }
        }
    }
    __syncthreads();
    if (R.router) { if (F.tid < 8) R.cnt[F.blk * 8 + F.tid] = hist[F.tid]; }
}

__device__ __forceinline__ void phase_scatter(const Frame& F0) {
    Frame F = F0; asm volatile("" : "+v"(F.tid)); F.lane = F.tid & 63;
    LAS int* cntL = (LAS int*)F.lds; LAS int* totL = cntL + 2048; LAS int* preL = totL + 8; LAS int* tsL = preL + 8; LAS int* slotL = tsL + 16;
    const int* cnt = (const int*)(F.ws + WS_CNT); const int* tope = (const int*)(F.ws + WS_TOPE); int* slot = (int*)(F.ws + WS_SLOT); int* meta = (int*)(F.ws + WS_META);
    const bf16* hb = (const bf16*)(F.ws + WS_HB); unsigned char* as = (unsigned char*)(F.ws + WS_AS);
    for (int i = F.tid; i < 2048; i += NTHREADS) cntL[i] = cnt[i];
    __syncthreads();
    { const int e = F.wave; float tot = 0.f, pre = 0.f;
#pragma unroll
      for (int j = 0; j < 4; ++j) { const int c = F.lane + 64 * j; const float v = (float)cntL[c * 8 + e]; pre += (c < F.blk) ? v : 0.f; tot += v; }
      tot = wave_sum(tot); pre = wave_sum(pre);
      if (F.lane == 0) { totL[e] = (int)tot; preL[e] = (int)pre; } }
    __syncthreads();
    if (F.tid == 0) { int t = 0; for (int e = 0; e < 8; ++e) { tsL[e] = t; t += (totL[e] + 255) >> 8; } tsL[8] = t;
        if (F.blk == 0) { for (int e = 0; e <= 8; ++e) meta[e] = tsL[e]; for (int e = 0; e < 8; ++e) meta[9 + e] = totL[e];
            const int r = t & 31, ns = (r == 0 || r > 16) ? 1 : (r <= 8 ? 4 : 2), rs = ns == 1 ? 0 : r;
            meta[20] = rs; meta[21] = ns; meta[22] = (t - rs) * 256; } }
    __syncthreads();
    if (F.wave == 0) { const int tok = F.blk * 64 + F.lane; const int e1 = tope[2 * tok], e2 = tope[2 * tok + 1]; int s1 = 0, s2 = 0;
        const unsigned long long lt = (1ull << F.lane) - 1ull;
#pragma unroll
        for (int e = 0; e < 8; ++e) { const unsigned long long mk = __ballot(e1 == e || e2 == e); const int pos = tsL[e] * 256 + preL[e] + __popcll(mk & lt);
            if (e1 == e) s1 = pos; if (e2 == e) s2 = pos; }
        slot[2 * tok] = s1; slot[2 * tok + 1] = s2; slotL[2 * F.lane] = s1; slotL[2 * F.lane + 1] = s2; }
    __syncthreads();
    { u32x4 ra[8], rb[8], rc[8], rd[8];
#pragma unroll
      for (int i = 0; i < 8; ++i) { const int tok = F.blk * 64 + F.wave * 8 + i; const u32x4* src = (const u32x4*)(hb + (size_t)tok * D) + 2 * F.lane;
          ra[i] = src[0]; rb[i] = src[1]; rc[i] = src[128]; rd[i] = src[129]; }
      asm volatile("" ::: "memory");
#pragma unroll
      for (int i = 0; i < 8; ++i) { const int t = F.wave * 8 + i; const int s1 = slotL[2 * t], s2 = slotL[2 * t + 1];
          u32x4 o0, o1;
          { const u32x4 a = ra[i], b = rb[i];
            o0.x = pg8::pk4_fp8(bf_lo(a.x), bf_hi(a.x), bf_lo(a.y), bf_hi(a.y)); o0.y = pg8::pk4_fp8(bf_lo(a.z), bf_hi(a.z), bf_lo(a.w), bf_hi(a.w));
            o0.z = pg8::pk4_fp8(bf_lo(b.x), bf_hi(b.x), bf_lo(b.y), bf_hi(b.y)); o0.w = pg8::pk4_fp8(bf_lo(b.z), bf_hi(b.z), bf_lo(b.w), bf_hi(b.w)); }
          { const u32x4 a = rc[i], b = rd[i];
            o1.x = pg8::pk4_fp8(bf_lo(a.x), bf_hi(a.x), bf_lo(a.y), bf_hi(a.y)); o1.y = pg8::pk4_fp8(bf_lo(a.z), bf_hi(a.z), bf_lo(a.w), bf_hi(a.w));
            o1.z = pg8::pk4_fp8(bf_lo(b.x), bf_hi(b.x), bf_lo(b.y), bf_hi(b.y)); o1.w = pg8::pk4_fp8(bf_lo(b.z), bf_hi(b.z), bf_lo(b.w), bf_hi(b.w)); }
          u32x4* d1 = (u32x4*)(as + (size_t)s1 * D) + F.lane; u32x4* d2 = (u32x4*)(as + (size_t)s2 * D) + F.lane;
          d1[0] = o0; d1[64] = o1; d2[0] = o0; d2[64] = o1; } }
    { const int e = F.wave; const int npad = (tsL[e + 1] - tsL[e]) * 256 - totL[e];
      if (F.blk < npad) { u32x4* d = (u32x4*)(as + (size_t)(tsL[e] * 256 + totL[e] + F.blk) * D) + F.lane;
          d[0] = (u32x4){0u, 0u, 0u, 0u}; d[64] = (u32x4){0u, 0u, 0u, 0u}; } }
    __syncthreads();
}

__device__ __forceinline__ void fgate_scan(const Frame& F0) {
    Frame F = F0; asm volatile("" : "+v"(F.tid)); F.lane = F.tid & 63;
    if (F.blk < 48 && F.wave == 0) { const float* lf = (const float*)(F.ws + WS_LOGF) + (size_t)F.blk * SEQ + F.lane * 32; float* fb = (float*)(F.ws + WS_FB) + (size_t)F.blk * SEQ + F.lane * 32;
        f32x4 v[8]; float run = 0.f;
#pragma unroll
        for (int j = 0; j < 8; ++j) { v[j] = ((const f32x4*)lf)[j];
#pragma unroll
            for (int k = 0; k < 4; ++k) { run += v[j][k]; v[j][k] = run; } }
        LAS float* tl = (LAS float*)(F.lds + MISC_OFF + 256); tl[F.lane] = run; LDS_WAIT(); asm volatile("" ::: "memory");
        float excl = 0.f;
        for (int k = 0; k < 64; ++k) { const float t = tl[k]; excl += (k < F.lane) ? t : 0.f; }
#pragma unroll
        for (int j = 0; j < 8; ++j) ((f32x4*)fb)[j] = (v[j] + excl) * (-LOG2E); }
}
#define ATT_STEP(KROW, VROW, BIAS, VALID) do {                                                                                              \
        const u32x4* kp_ = (const u32x4*)(KROW); float dot_ = 0.f;                                                                         \
        _Pragma("unroll") for (int c_ = 0; c_ < 4; ++c_) { const u32x4 w_ = kp_[c_];                                                      \
            dot_ += qf[8 * c_ + 0] * bf_lo(w_.x) + qf[8 * c_ + 1] * bf_hi(w_.x) + qf[8 * c_ + 2] * bf_lo(w_.y) + qf[8 * c_ + 3] * bf_hi(w_.y)   \
                  + qf[8 * c_ + 4] * bf_lo(w_.z) + qf[8 * c_ + 5] * bf_hi(w_.z) + qf[8 * c_ + 6] * bf_lo(w_.w) + qf[8 * c_ + 7] * bf_hi(w_.w); }  \
        dot_ += SWZ_XOR(dot_, 1); dot_ += SWZ_XOR(dot_, 2);                                                                           \
        const bool ok_ = (VALID); const float sc_ = dot_ + (BIAS);                                                                          \
        const float mn_ = ok_ ? fmaxf(mrun, sc_) : mrun; const float al_ = __builtin_amdgcn_exp2f(mrun - mn_); const float p_ = ok_ ? __builtin_amdgcn_exp2f(sc_ - mn_) : 0.f;   \
        mrun = mn_; lrun = lrun * al_ + p_;                                                                                                 \
        const u32x4* vp_ = (const u32x4*)(VROW);                                                                                            \
        _Pragma("unroll") for (int c_ = 0; c_ < 4; ++c_) { const u32x4 w_ = vp_[c_];                                                      \
            of[8 * c_ + 0] = of[8 * c_ + 0] * al_ + p_ * bf_lo(w_.x); of[8 * c_ + 1] = of[8 * c_ + 1] * al_ + p_ * bf_hi(w_.x);             \
            of[8 * c_ + 2] = of[8 * c_ + 2] * al_ + p_ * bf_lo(w_.y); of[8 * c_ + 3] = of[8 * c_ + 3] * al_ + p_ * bf_hi(w_.y);             \
            of[8 * c_ + 4] = of[8 * c_ + 4] * al_ + p_ * bf_lo(w_.z); of[8 * c_ + 5] = of[8 * c_ + 5] * al_ + p_ * bf_hi(w_.z);             \
            of[8 * c_ + 6] = of[8 * c_ + 6] * al_ + p_ * bf_lo(w_.w); of[8 * c_ + 7] = of[8 * c_ + 7] * al_ + p_ * bf_hi(w_.w); }           \
    } while (0)
__device__ __forceinline__ void phase_attn_naive(const Frame& F0, int layer) {
    Frame F = F0; asm volatile("" : "+v"(F.tid)); F.lane = F.tid & 63;
    const bf16* Qb = (const bf16*)(F.ws + WS_BIG); const bf16* Kb = Qb + (size_t)M * D; const bf16* Vb = Kb + (size_t)M * D; bf16* Ob = (bf16*)(F.ws + WS_HB);
    const float* fbase = (const float*)(F.ws + WS_FB); const float* kmb = (const float*)(F.ws + WS_CTL + CTL_KM) + (size_t)layer * 32768;
    const int part = F.tid & 3, ql = F.tid >> 2;
    for (int item = F.blk; item < BATCH * NH * 16; item += F.G) {
        const int bh = item >> 4, qc = item & 15, b = bh >> 4, h = bh & 15, t = qc * 128 + ql;
        const bf16* Qh = Qb + (size_t)bh * SEQ * HD; const bf16* Kh = Kb + (size_t)bh * SEQ * HD + part * 32; const bf16* Vh = Vb + (size_t)bh * SEQ * HD + part * 32;
        float qf[32], of[32]; float mrun = -1.0e30f, lrun = 0.f;
        { const u32x4* qp = (const u32x4*)(Qh + (size_t)t * HD + part * 32);
#pragma unroll
          for (int c = 0; c < 4; ++c) { const u32x4 w = qp[c]; qf[8 * c] = bf_lo(w.x); qf[8 * c + 1] = bf_hi(w.x); qf[8 * c + 2] = bf_lo(w.y); qf[8 * c + 3] = bf_hi(w.y);
              qf[8 * c + 4] = bf_lo(w.z); qf[8 * c + 5] = bf_hi(w.z); qf[8 * c + 6] = bf_lo(w.w); qf[8 * c + 7] = bf_hi(w.w); } }
#pragma unroll
        for (int i = 0; i < 32; ++i) of[i] = 0.f;
        const int tmax = qc * 128 + (F.wave * 16 + 15);
        if (h < 6) {
            for (int br = 0; br < 3; ++br) { const int dl = br == 0 ? 1 : (br == 1 ? 4 : 16);
                for (int j = 0; j <= 128; ++j) { const int s = t - j * dl; const bool ok = s >= 0; const int sr = ok ? s : 0;
                    ATT_STEP(Kh + (size_t)sr * HD, Vh + (size_t)sr * HD, 0.f, ok); } }
        } else if (h < 10) {
            const int cur = t >> 8; const float* km = kmb + (size_t)((b * 4 + (h - 6)) * 8) * 128 + part * 32;
            float g[7];
#pragma unroll
            for (int n = 0; n < 7; ++n) { float s = 0.f; if (n < cur) {
#pragma unroll
                    for (int i = 0; i < 32; ++i) s += qf[i] * km[n * 128 + i]; }
                s += SWZ_XOR(s, 1); s += SWZ_XOR(s, 2); g[n] = s; }
            unsigned mask = 1u << cur;
#pragma unroll
            for (int r = 0; r < 3; ++r) { float best = -3.0e38f; int bi = -1;
#pragma unroll
                for (int n = 0; n < 7; ++n) if (n < cur && !((mask >> n) & 1u) && g[n] > best) { best = g[n]; bi = n; }
                if (bi >= 0) mask |= 1u << bi; }
            for (int s = 0; s <= tmax; ++s) { const bool ok = (s <= t) && ((mask >> (s >> 8)) & 1u);
                ATT_STEP(Kh + (size_t)s * HD, Vh + (size_t)s * HD, 0.f, ok); }
        } else {
            const float* fb = fbase + (size_t)(b * 6 + (h - 10)) * SEQ; const float ft = fb[t];
            for (int s = 0; s <= tmax; ++s) { const bool ok = s <= t;
                ATT_STEP(Kh + (size_t)s * HD, Vh + (size_t)s * HD, fb[s] - ft, ok); }
        }
        const float rl = 1.0f / lrun;
        u32x4* op = (u32x4*)(Ob + (size_t)(b * SEQ + t) * D + h * HD + part * 32);
#pragma unroll
        for (int c = 0; c < 4; ++c) { u32x4 w; w.x = pk2(of[8 * c] * rl, of[8 * c + 1] * rl); w.y = pk2(of[8 * c + 2] * rl, of[8 * c + 3] * rl);
            w.z = pk2(of[8 * c + 4] * rl, of[8 * c + 5] * rl); w.w = pk2(of[8 * c + 6] * rl, of[8 * c + 7] * rl); op[c] = w; }
    }
}
namespace att {
constexpr int D = 128;
constexpr float THR2 = 11.541560327111707f;
constexpr int OPITCH = 2048;
constexpr bool WSKIP = false;
constexpr int NW = 8, QBLK = 32, KVBLK = 64, QB = NW * QBLK;
constexpr int SHM_V = KVBLK * D * 2, SHM_K = KVBLK * D * 2;
constexpr int LUT_N = 2368, LUT_OFF = 68608, KBT_OFF = LUT_OFF + LUT_N * 4, KM_OFF = KBT_OFF + 8192, ZERO_OFF = KM_OFF + 4096, NINF_OFF = ZERO_OFF + 256, ATT_LDS_END = NINF_OFF + 256;
typedef unsigned short bf16;
__device__ __forceinline__ int att_tid() { int t = threadIdx.x; asm volatile("" : "+v"(t)); return t; }
typedef short bf16x8 __attribute__((ext_vector_type(8)));
typedef short s16x4 __attribute__((ext_vector_type(4)));
typedef float f32x16 __attribute__((ext_vector_type(16)));
typedef float f32x4 __attribute__((ext_vector_type(4)));
typedef unsigned u32x4 __attribute__((ext_vector_type(4)));
template <class A, class Bt> struct same_t { static constexpr bool v = false; };
template <class A> struct same_t<A, A> { static constexpr bool v = true; };

#define KSWZ(row, colB) ((row) * 256 + ((colB) ^ (((row) & 7) << 4)))
#define SBAR() __builtin_amdgcn_sched_barrier(0)
__device__ __forceinline__ int v_st(int k, int c) { const int kk = (k & ~0xC) | ((k & 4) << 1) | ((k & 8) >> 1); return ((kk >> 3) * 4 + (c >> 5)) * 512 + ((kk & 7) * 32 + (c & 31)) * 2; }
__device__ __forceinline__ int v_rd_base(int lane) { return ((lane & 3) << 3) | (((lane >> 2) & 3) << 6) | (((lane >> 4) & 1) << 5) | (((lane >> 5) & 1) << 8); }
constexpr int v_rd_off(int d0, int ks, int half) { return d0 * 512 + ks * 4096 + half * 2048; }
__device__ __forceinline__ int crow(int r, int hi) { return (r & 3) + 8 * (r >> 2) + 4 * hi; }
__device__ __forceinline__ unsigned cvtpk(float lo, float hi) {
    unsigned r; asm volatile("v_cvt_pk_bf16_f32 %0, %1, %2" : "=v"(r) : "v"(lo), "v"(hi)); return r;
}
__device__ __forceinline__ bf16x8 pack8(f32x4 a, f32x4 b) {
    u32x4 w = {cvtpk(a[0], a[1]), cvtpk(a[2], a[3]), cvtpk(b[0], b[1]), cvtpk(b[2], b[3])};
    return *reinterpret_cast<bf16x8*>(&w);
}
template <class T> __device__ __forceinline__ bf16x8 load8(const T* p) {
    if constexpr (same_t<T, float>::v) { return pack8(*(const f32x4*)p, *(const f32x4*)(p + 4)); }
    else { return *reinterpret_cast<const bf16x8*>(p); }
}
__device__ __forceinline__ void mask_tile(f32x16& p0, f32x16& p1, int dq, unsigned W) {
    const float NEG = -__builtin_inff();
#pragma unroll
    for (int r = 0; r < 16; ++r) {
        const int c = (r & 3) + 8 * (r >> 2);
        if ((unsigned)(dq - c) >= W) p0[r] = NEG;
        if ((unsigned)(dq - c - 32) >= W) p1[r] = NEG;
    }
}
struct BiasCtx { int mode; unsigned lut, kbt, zero, ninf, qmask; };
__device__ __forceinline__ void bias_tile(f32x16& p0, f32x16& p1, unsigned va) {
#pragma unroll
    for (int g = 0; g < 4; ++g) {
#pragma unroll
        for (int k = 0; k < 4; ++k) { const int r = 4 * g + k, c = (r & 3) + 8 * (r >> 2);
            p0[r] += *(const __attribute__((address_space(3))) float*)(va + 4 * c);
            p1[r] += *(const __attribute__((address_space(3))) float*)(va + 4 * (c + 32)); }
        __builtin_amdgcn_sched_barrier(0); }
}
__device__ __forceinline__ void partialSM(f32x16& p0, f32x16& p1, float& m_reg, float& mn, float& alpha) {
    float pmax = p0[0]; for (int r = 1; r < 16; ++r) pmax = fmaxf(pmax, p0[r]); for (int r = 0; r < 16; ++r) pmax = fmaxf(pmax, p1[r]);
    { auto rr = __builtin_amdgcn_permlane32_swap(__float_as_uint(pmax), __float_as_uint(pmax), false, false);
      pmax = fmaxf(__uint_as_float(rr[0]), __uint_as_float(rr[1])); }
    if (__builtin_expect(__all((pmax - m_reg) <= THR2), 1)) { mn = m_reg; alpha = 1.f; }
    else { mn = fmaxf(m_reg, pmax); alpha = __builtin_amdgcn_exp2f(m_reg - mn); m_reg = mn; }
    for (int r = 0; r < 16; ++r) p0[r] = p0[r] - mn; for (int r = 0; r < 16; ++r) p1[r] = p1[r] - mn;
    for (int r = 0; r < 16; ++r) p0[r] = __builtin_amdgcn_exp2f(p0[r]);
}
__device__ __forceinline__ void finishSM(f32x16& p0, f32x16& p1, float alpha, float& l_reg, bf16x8& pa0, bf16x8& pa1, bf16x8& pa2, bf16x8& pa3) {
    for (int r = 0; r < 16; ++r) p1[r] = __builtin_amdgcn_exp2f(p1[r]);
    float ps = 0; for (int r = 0; r < 16; ++r) ps += p0[r]; for (int r = 0; r < 16; ++r) ps += p1[r];
    { auto rr = __builtin_amdgcn_permlane32_swap(__float_as_uint(ps), __float_as_uint(ps), false, false);
      ps = __uint_as_float(rr[0]) + __uint_as_float(rr[1]); }
    l_reg = l_reg * alpha + ps;
#define PK4(P, B_, OUT) do { unsigned a0 = cvtpk(P[B_+0], P[B_+1]), a1 = cvtpk(P[B_+2], P[B_+3]);                          \
        unsigned b0 = cvtpk(P[B_+4], P[B_+5]), b1 = cvtpk(P[B_+6], P[B_+7]);                                             \
        auto r0 = __builtin_amdgcn_permlane32_swap(a0, b0, false, false); auto r1 = __builtin_amdgcn_permlane32_swap(a1, b1, false, false); \
        u32x4 w = {r0[0], r1[0], r0[1], r1[1]}; OUT = *reinterpret_cast<bf16x8*>(&w); } while (0)
    PK4(p0, 0, pa0); PK4(p0, 8, pa1); PK4(p1, 0, pa2); PK4(p1, 8, pa3);
#undef PK4
}
template <int KB, bool SK>
__device__ __forceinline__ void qkt(f32x16& p0, f32x16& p1, const char* K_lds, int r32, int hi, const bf16x8* qr, bool act) {
    if (SK && !act) { const float NEG = -__builtin_inff();
#pragma unroll
        for (int r = 0; r < 16; ++r) { p0[r] = NEG; p1[r] = NEG; } return; }
    p0 = f32x16{}; p1 = f32x16{};
    const char* kb[4];
#pragma unroll
    for (int dd = 0; dd < 4; ++dd) kb[dd] = K_lds + KB * SHM_K + KSWZ(r32, (dd * 16 + hi * 8) * 2);
#pragma unroll
    for (int d0 = 0; d0 < 8; ++d0) { const char* a = kb[d0 & 3] + (d0 >> 2) * 128;
        bf16x8 b0 = *reinterpret_cast<const bf16x8*>(a);
        bf16x8 b1 = *reinterpret_cast<const bf16x8*>(a + 32 * 256);
        p0 = __builtin_amdgcn_mfma_f32_32x32x16_bf16(b0, qr[d0], p0, 0, 0, 0);
        p1 = __builtin_amdgcn_mfma_f32_32x32x16_bf16(b1, qr[d0], p1, 0, 0, 0); }
}
template <int VB, bool SK>
__device__ __forceinline__ void pv_tile(f32x16* o, int vb0, bf16x8 pa0, bf16x8 pa1, bf16x8 pa2, bf16x8 pa3, bool act) {
    if (SK && !act) return;
#define TRRD(dst, off) asm volatile("ds_read_b64_tr_b16 %0, %1 offset:%2" : "=&v"(dst) : "v"(vb0), "i"(off) : "memory")
#define PV_D0(d0) do { s16x4 l0, l1, l2, l3, h0, h1, h2, h3; constexpr int b_ = VB * SHM_V + v_rd_off(d0, 0, 0);     \
        TRRD(l0, b_); TRRD(h0, b_ + 2048); TRRD(l1, b_ + 4096); TRRD(h1, b_ + 6144); TRRD(l2, b_ + 8192); TRRD(h2, b_ + 10240); TRRD(l3, b_ + 12288); TRRD(h3, b_ + 14336); \
        asm volatile("s_waitcnt lgkmcnt(0)" ::: "memory"); SBAR();                 \
        o[d0] = __builtin_amdgcn_mfma_f32_32x32x16_bf16(pa0, (bf16x8){l0[0], l0[1], l0[2], l0[3], h0[0], h0[1], h0[2], h0[3]}, o[d0], 0, 0, 0);   \
        o[d0] = __builtin_amdgcn_mfma_f32_32x32x16_bf16(pa1, (bf16x8){l1[0], l1[1], l1[2], l1[3], h1[0], h1[1], h1[2], h1[3]}, o[d0], 0, 0, 0);   \
        o[d0] = __builtin_amdgcn_mfma_f32_32x32x16_bf16(pa2, (bf16x8){l2[0], l2[1], l2[2], l2[3], h2[0], h2[1], h2[2], h2[3]}, o[d0], 0, 0, 0);   \
        o[d0] = __builtin_amdgcn_mfma_f32_32x32x16_bf16(pa3, (bf16x8){l3[0], l3[1], l3[2], l3[3], h3[0], h3[1], h3[2], h3[3]}, o[d0], 0, 0, 0); } while (0)
    PV_D0(0); PV_D0(1); PV_D0(2); PV_D0(3);
#undef PV_D0
#undef TRRD
}

template <class TIn, class TOut> struct BlockRef { const TIn* Q; const TIn* K; const TIn* V; TOut* O; int P0; };
template <class TIn> struct Seam {
    bf16x8 qr[8];
    bf16x8 st_v0, st_v1, st_k0, st_k1; f32x4 sf0, sf1, sf2, sf3;
    f32x4 tq[16];
};
__device__ __forceinline__ int swa_jlo(int P0, int W) { const int lowk = P0 - W + 1; return lowk > 0 ? lowk / KVBLK : 0; }
#define ROW(p, k0, rr) ((p) + (size_t)((k0) + (rr)) * D + sc)
#define VMW() asm volatile("s_waitcnt vmcnt(0)" ::: "memory")
#define VMWN(n) asm volatile("s_waitcnt vmcnt(%0)" :: "i"(n) : "memory")
#define SLOAD_H(Kp, Vp, k0) do { S.st_v0 = load8<TIn>(ROW(Vp, k0, sr)); S.st_v1 = load8<TIn>(ROW(Vp, k0, 32 + sr));              \
                         S.st_k0 = load8<TIn>(ROW(Kp, k0, sr)); S.st_k1 = load8<TIn>(ROW(Kp, k0, 32 + sr)); } while (0)
#define SWRITE_HK(bf) do { *(bf16x8*)(K_lds + (bf) * SHM_K + kws) = S.st_k0; *(bf16x8*)(K_lds + (bf) * SHM_K + kws + 32 * 256) = S.st_k1; } while (0)
#define SWRITE_HV(bf) do { *(bf16x8*)(V_lds + (bf) * SHM_V + vst0) = S.st_v0; *(bf16x8*)(V_lds + (bf) * SHM_V + vst1) = S.st_v1; } while (0)
#define SWRITE_H(bf) do { SWRITE_HV(bf); SWRITE_HK(bf); } while (0)
#define SLOAD_F(p, k0) do { S.sf0 = *(const f32x4*)ROW(p, k0, sr); S.sf1 = *(const f32x4*)(ROW(p, k0, sr) + 4);                \
                            S.sf2 = *(const f32x4*)ROW(p, k0, 32 + sr); S.sf3 = *(const f32x4*)(ROW(p, k0, 32 + sr) + 4); } while (0)
#define SWRITE_KF(bf) do { *(bf16x8*)(K_lds + (bf) * SHM_K + kws) = pack8(S.sf0, S.sf1); *(bf16x8*)(K_lds + (bf) * SHM_K + kws + 32 * 256) = pack8(S.sf2, S.sf3); } while (0)
#define SWRITE_VF(bf) do { *(bf16x8*)(V_lds + (bf) * SHM_V + vst0) = pack8(S.sf0, S.sf1); *(bf16x8*)(V_lds + (bf) * SHM_V + vst1) = pack8(S.sf2, S.sf3); } while (0)
template <class TIn, class TOut>
__device__ __forceinline__ void causal_swa_prime(const BlockRef<TIn, TOut>& cur, int W, char* lds, Seam<TIn>& S) {
    constexpr bool F32 = same_t<TIn, float>::v;
    const int tid = att_tid(), wid = __builtin_amdgcn_readfirstlane(tid >> 6), lane = tid & 63, r32 = lane & 31, hi = lane >> 5;
    const int sr = tid >> 4, sc = (tid & 15) * 8, kws = KSWZ(sr, sc * 2); char* K_lds = lds + 2 * SHM_V;
    const int kb0 = swa_jlo(cur.P0, W) * KVBLK;
    for (int d0 = 0; d0 < 8; ++d0) S.qr[d0] = load8<TIn>(cur.Q + (size_t)(wid * QBLK + r32) * D + d0 * 16 + hi * 8);
    if constexpr (F32) { SLOAD_F((const float*)cur.K, kb0); VMW(); SWRITE_KF(0); SBAR(); SLOAD_F((const float*)cur.V, kb0); }
    else { SLOAD_H(cur.K, cur.V, kb0); VMW(); SWRITE_HK(0); }
    __syncthreads();
}
template <class TIn, class TOut>
__device__ __forceinline__ void causal_swa_block(const BlockRef<TIn, TOut>& cur, const BlockRef<TIn, TOut>& nxt, int skv, int W, char* lds, Seam<TIn>& S, const BiasCtx& bc) {
    constexpr bool F32 = same_t<TIn, float>::v;
    const int tid = att_tid(), wid = __builtin_amdgcn_readfirstlane(tid >> 6), lane = tid & 63, r32 = lane & 31, hi = lane >> 5;
    const int j_lo = swa_jlo(cur.P0, W);
    int j_hi = (cur.P0 + QB - 1) / KVBLK + 1; if (j_hi > skv / KVBLK) j_hi = skv / KVBLK;
    const int NT = j_hi - j_lo;
    const int kbn = swa_jlo(nxt.P0, W) * KVBLK;
    const int qlo = cur.P0 + wid * QBLK, qm = qlo + r32 - 4 * hi;
    char* V_lds = lds; char* K_lds = lds + 2 * SHM_V;
    float* ws = (float*)(lds + 2 * SHM_V + 2 * SHM_K) + wid * 64; float* li_l = ws, * al_l = ws + 32;
    float m_reg = -1e30f, l_reg = 0; f32x16 o[4] = {};
    const int sr = tid >> 4, sc = (tid & 15) * 8, vst0 = v_st(sr, sc), vst1 = v_st(32 + sr, sc), kws = KSWZ(sr, sc * 2);
    const int vb0 = (int)(uintptr_t)V_lds + v_rd_base(lane);
    const TIn* Kh = cur.K; const TIn* Vh = cur.V;
#define RESC(a) do { if (__any((a) < 1.f)) { if (hi == 0) al_l[r32] = (a); asm volatile("s_waitcnt lgkmcnt(0)" ::: "memory");              \
                     for (int d_ = 0; d_ < 4; ++d_) for (int r = 0; r < 16; ++r) o[d_][r] *= al_l[crow(r, hi)]; } } while (0)
#define KBASE(t) ((j_lo + (t)) * KVBLK)
#define ACT(t) (KBASE(t) <= qlo + QBLK - 1 && KBASE(t) + KVBLK - 1 >= qlo - W + 1)
#define MASKT(P0_, P1_, t) do { const int kb_ = KBASE(t); unsigned va_;                                                              \
        if (bc.mode == 0) va_ = bc.lut + 4u * (unsigned)(2047 - qm + kb_);                                \
        else if (bc.mode == 1) va_ = ((bc.qmask >> (kb_ >> 8)) & 1u) ? bc.zero : bc.ninf;        \
        else va_ = bc.kbt + 4u * (unsigned)(kb_ + 4 * hi);                                                        \
        bias_tile(P0_, P1_, va_);                                                                                                         \
        if (kb_ + KVBLK - 1 > qlo) mask_tile(P0_, P1_, qm - kb_, 0x7fffffffu); } while (0)
    constexpr int NQL = F32 ? 16 : 8;
    constexpr bool SK = WSKIP && !F32;
#define SEAM_K0() do { VMWN(NQL); if constexpr (F32) { SWRITE_KF(0); SBAR(); SLOAD_F((const float*)nxt.V, kbn); } else { SWRITE_HK(0); } SBAR(); } while (0)
    f32x16 pA0, pA1, pB0, pB1; float mnA, mnB, alA, alB; bf16x8 pa0, pa1, pa2, pa3;
    if constexpr (F32) { VMW(); SWRITE_VF(0); SBAR(); } else { SWRITE_HV(0); SBAR(); }
    if (NT > 1) { if constexpr (F32) SLOAD_F((const float*)Kh, KBASE(1)); else SLOAD_H(Kh, Vh, KBASE(1)); }
    SBAR(); qkt<0, SK>(pA0, pA1, K_lds, r32, hi, S.qr, ACT(0));
    if constexpr (F32) { if (NT > 1) { VMW(); SWRITE_KF(1); SBAR(); SLOAD_F((const float*)Vh, KBASE(1)); } }
    MASKT(pA0, pA1, 0); partialSM(pA0, pA1, m_reg, mnA, alA);
    if (NT > 1) { VMW(); if constexpr (F32) { SWRITE_VF(1); SBAR(); if (NT > 2) SLOAD_F((const float*)Kh, KBASE(2)); } else SWRITE_H(1); }
    __syncthreads();
#define HALF_STEP(PX0, PX1, mnX, alX, PY0, PY1, alY, t, KB, VB, SB) do {                                                      \
        SBAR(); qkt<KB, SK>(PX0, PX1, K_lds, r32, hi, S.qr, ACT(t));                                             \
        finishSM(PY0, PY1, alY, l_reg, pa0, pa1, pa2, pa3); SBAR();                                                           \
        if ((t) + 1 < NT) { if constexpr (F32) { VMW(); SWRITE_KF(SB); SBAR(); SLOAD_F((const float*)Vh, KBASE((t) + 1)); }  \
                            else { SLOAD_H(Kh, Vh, KBASE((t) + 1)); } SBAR(); }                                               \
        pv_tile<VB, SK>(o, vb0, pa0, pa1, pa2, pa3, ACT((t) - 1)); MASKT(PX0, PX1, (t)); partialSM(PX0, PX1, m_reg, mnX, alX);                                        \
        __syncthreads();                                                                                                      \
        if ((t) + 1 < NT) { VMW(); if constexpr (F32) { SWRITE_VF(SB); SBAR(); if ((t) + 2 < NT) SLOAD_F((const float*)Kh, KBASE((t) + 2)); } \
                            else { SWRITE_H(SB); } }                                                                          \
        RESC(alX); __syncthreads(); } while (0)
    for (int t = 1; t + 1 < NT; t += 2) {
        HALF_STEP(pB0, pB1, mnB, alB, pA0, pA1, alA, t, 1, 0, 0);
        HALF_STEP(pA0, pA1, mnA, alA, pB0, pB1, alB, t + 1, 0, 1, 1);
    }
    const bool even = (NT & 1) == 0;
    if (even) { SBAR(); qkt<1, SK>(pB0, pB1, K_lds, r32, hi, S.qr, ACT(NT - 1)); SBAR(); }
#define QROW(e) (nxt.Q + (size_t)(wid * QBLK + r32) * D + ((e) >> 1) * 16 + hi * 8 + ((e) & 1) * 4)
    if constexpr (F32) { SLOAD_F((const float*)nxt.K, kbn); SBAR();
#pragma unroll
        for (int e = 0; e < 8; ++e) S.tq[e] = *(const f32x4*)QROW(e); }
    else { SLOAD_H(nxt.K, nxt.V, kbn); SBAR();
#pragma unroll
        for (int d0 = 0; d0 < 8; ++d0) S.qr[d0] = load8<TIn>(nxt.Q + (size_t)(wid * QBLK + r32) * D + d0 * 16 + hi * 8); }
    SBAR();
    finishSM(pA0, pA1, alA, l_reg, pa0, pa1, pa2, pa3); SBAR();
    if constexpr (F32) {
#pragma unroll
        for (int e = 8; e < 16; ++e) S.tq[e] = *(const f32x4*)QROW(e); SBAR(); }
#undef QROW
    pv_tile<0, SK>(o, vb0, pa0, pa1, pa2, pa3, ACT(even ? NT - 2 : NT - 1));
    if (even) { MASKT(pB0, pB1, NT - 1); partialSM(pB0, pB1, m_reg, mnB, alB); __syncthreads(); RESC(alB);
        finishSM(pB0, pB1, alB, l_reg, pa0, pa1, pa2, pa3); SBAR(); pv_tile<1, SK>(o, vb0, pa0, pa1, pa2, pa3, ACT(NT - 1)); }
    SBAR(); SEAM_K0();
    if (hi == 0) li_l[r32] = l_reg; asm volatile("s_waitcnt lgkmcnt(0)" ::: "memory");
    float rli[16];
#pragma unroll
    for (int r = 0; r < 16; ++r) rli[r] = __builtin_amdgcn_rcpf(li_l[crow(r, hi)]);
    TOut* Ow = cur.O + (size_t)(wid * QBLK) * OPITCH;
#pragma unroll
    for (int r = 0; r < 16; ++r) { const int orow = crow(r, hi);
#pragma unroll
        for (int d0 = 0; d0 < 4; ++d0) { const float v = o[d0][r] * rli[r];
            if constexpr (same_t<TOut, float>::v) { Ow[(size_t)orow * OPITCH + d0 * 32 + r32] = v; }
            else { const float vn = __builtin_bit_cast(float, __builtin_amdgcn_ds_swizzle(__builtin_bit_cast(int, v), (1 << 10) | 0x1F));
                   if ((r32 & 1) == 0) *(unsigned*)(Ow + (size_t)orow * OPITCH + d0 * 32 + r32) = cvtpk(v, vn); } } }
    if constexpr (F32) {
#pragma unroll
        for (int d0 = 0; d0 < 8; ++d0) S.qr[d0] = pack8(S.tq[2 * d0], S.tq[2 * d0 + 1]); }
    __syncthreads();
#undef RESC
#undef KBASE
#undef ACT
#undef MASKT
#undef SEAM_K0
#undef HALF_STEP
}
#undef ROW
#undef VMW
#undef VMWN
#undef SLOAD_H
#undef SWRITE_HK
#undef SWRITE_HV
#undef SWRITE_H
#undef SLOAD_F
#undef SWRITE_KF
#undef SWRITE_VF
__device__ __forceinline__ unsigned moba_mask(const bf16x8* qr, unsigned km_addr, int cur, int hi) {
    float g[7];
#pragma unroll
    for (int n = 0; n < 7; ++n) g[n] = 0.f;
#pragma unroll
    for (int d0 = 0; d0 < 8; ++d0) { float q[8];
#pragma unroll
        for (int e = 0; e < 8; ++e) q[e] = __uint_as_float(((unsigned)(unsigned short)qr[d0][e]) << 16);
#pragma unroll
        for (int n = 0; n < 7; ++n) if (n < cur) { const unsigned a = km_addr + (unsigned)(n * 128 + d0 * 16 + hi * 8) * 4u;
            const f32x4 k0 = *(const __attribute__((address_space(3))) f32x4*)a, k1 = *(const __attribute__((address_space(3))) f32x4*)(a + 16);
            g[n] += (q[0] * k0[0] + q[1] * k0[1]) + (q[2] * k0[2] + q[3] * k0[3]) + (q[4] * k1[0] + q[5] * k1[1]) + (q[6] * k1[2] + q[7] * k1[3]); } }
#pragma unroll
    for (int n = 0; n < 7; ++n) { const auto rr = __builtin_amdgcn_permlane32_swap(__float_as_uint(g[n]), __float_as_uint(g[n]), false, false); g[n] = __uint_as_float(rr[0]) + __uint_as_float(rr[1]); }
    unsigned mask = 1u << cur;
#pragma unroll
    for (int r = 0; r < 3; ++r) { float best = -3.0e38f; int bi = -1;
#pragma unroll
        for (int n = 0; n < 7; ++n) if (n < cur && !((mask >> n) & 1u) && g[n] > best) { best = g[n]; bi = n; }
        if (bi >= 0) mask |= 1u << bi; }
    return mask;
}
__device__ __forceinline__ BlockRef<bf16, bf16> mk_ref(int L, int pass, const bf16* Q, const bf16* K, const bf16* V, bf16* O) {
    const int bh = L >> 2, x = L & 3, qb = pass ? 7 - x : x, b = bh >> 4, h = bh & 15;
    BlockRef<bf16, bf16> r; r.Q = Q + ((size_t)bh * 2048 + (size_t)qb * QB) * D; r.K = K + (size_t)bh * 2048 * D; r.V = V + (size_t)bh * 2048 * D;
    r.O = O + ((size_t)(b * 2048 + qb * QB)) * OPITCH + h * D; r.P0 = qb * QB; return r;
}
__device__ __forceinline__ void attn_phase(char* lds, int tid, int blk, int G, const bf16* Q, const bf16* K, const bf16* V, bf16* O, const float* FB, const float* KMg) {
    const unsigned lbase = (unsigned)(uintptr_t)lds;
    { float* lut = (float*)(lds + LUT_OFF); const float NEG = -__builtin_inff();
      for (int j = tid; j < LUT_N; j += 512) { const int d = 2047 - j; float v = NEG;
          if (d >= 0) { const int m = (d <= 128 ? 1 : 0) + (((d & 3) == 0 && d <= 512) ? 1 : 0) + ((d & 15) == 0 ? 1 : 0); v = m == 0 ? NEG : (m == 1 ? 0.f : (m == 2 ? 1.f : 1.584962500721156f)); }
          lut[j] = v; }
      if (tid < 64) { ((float*)(lds + ZERO_OFF))[tid] = 0.f; ((float*)(lds + NINF_OFF))[tid] = NEG; } }
    __syncthreads();
    const int vcu = (G % 8 == 0) ? (blk % 8) * (G / 8) + blk / 8 : blk;
    constexpr int NITEMS = 8 * 16 * 4;
    int L = vcu; if (L >= NITEMS) return;
    int pass = 0;
    BlockRef<bf16, bf16> cur = mk_ref(L, 0, Q, K, V, O);
    Seam<bf16> S;
    causal_swa_prime<bf16, bf16>(cur, 0x40000000, lds, S);
    for (;;) {
        const bool more_pass = pass == 0, more_item = L + G < NITEMS, last = !more_pass && !more_item;
        int passn = pass + 1, Ln = L;
        if (!more_pass) { passn = 0; Ln = more_item ? L + G : L; }
        const BlockRef<bf16, bf16> nxt = last ? cur : mk_ref(Ln, passn, Q, K, V, O);
        const int bh = L >> 2, b = bh >> 4, h = bh & 15;
        BiasCtx bc; bc.mode = h < 6 ? 0 : (h < 10 ? 1 : 2); bc.lut = lbase + LUT_OFF; bc.kbt = lbase + KBT_OFF; bc.zero = lbase + ZERO_OFF; bc.ninf = lbase + NINF_OFF; bc.qmask = 0u;
        int t2 = tid; asm volatile("" : "+v"(t2));
        if (bc.mode == 2) { const float* fb = FB + (size_t)(b * 6 + (h - 10)) * 2048; if (t2 * 4 < cur.P0 + QB) *(f32x4*)(lds + KBT_OFF + t2 * 16) = *(const f32x4*)(fb + t2 * 4); }
        if (bc.mode == 1) { const float* km = KMg + (size_t)((b * 4 + (h - 6)) * 8) * 128; if (t2 < 256) *(f32x4*)(lds + KM_OFF + t2 * 16) = *(const f32x4*)(km + t2 * 4); }
        if (bc.mode != 0) __syncthreads();
        if (bc.mode == 1) bc.qmask = moba_mask(S.qr, lbase + KM_OFF, cur.P0 >> 8, (t2 & 63) >> 5);
        causal_swa_block<bf16, bf16>(cur, nxt, 2048, 0x40000000, lds, S, bc);
        if (last) break;
        cur = nxt; pass = passn; L = Ln;
    }
}
}

constexpr int NPHASES = 19;
#define IN(k) (lo <= (k) && (k) < hi)
#define SEAM(k) do { if (IN((k) + 1)) { KArgs ap_ = kargs(); XcdBarrier b2_; b2_.bar = (unsigned*)(ap_->ws + WS_CTL) + CW_BAR; b2_.x = xb_xcc_id(); b2_.st = (volatile LAS unsigned*)((LAS unsigned char*)lds_raw + MISC_OFF); xcd_barrier(b2_); } } while (0)
#define PHASE_SETUP() KArgs ap = kargs(); Frame F; F.lds = (LAS unsigned char*)lds_raw; F.tid = threadIdx.x; F.lane = F.tid & 63; F.wave = __builtin_amdgcn_readfirstlane(F.tid >> 6); F.blk = blockIdx.x; F.G = gridDim.x; asm volatile("" : "+s"(F.blk), "+s"(F.G)); F.ws = ap->ws; \
    const float* mod = (const float*)(F.ws + WS_MOD); bf16* HB = (bf16*)(F.ws + WS_HB); bf16* YB = (bf16*)(F.ws + WS_Y); bf16* BIG = (bf16*)(F.ws + WS_BIG); bf16* AS = (bf16*)(F.ws + WS_AS); bf16* YS = AS; (void)mod; (void)HB; (void)YB; (void)BIG; (void)AS; (void)YS

template <int l> __device__ __forceinline__ void layer_phases(unsigned char* lds_raw, const int lo, const int hi) {
        const int p0 = 2 + 8 * l;
        if (IN(p0)) { PHASE_SETUP(); const float* modl = mod + (size_t)l * BATCH * NMOD;
            RowArgs R{}; R.has_post = l; R.moe_y = 0; R.has_pre = 1; R.fg = 1; R.router = 0;
            R.xin = l == 0 ? (const float*)ap->in[0] : ap->out; R.xout = ap->out; R.Y = YB; R.gvec = mod + 5 * D; R.lnpost = (const float*)ap->in[6];
            if (X_BF16 && l == 1) { R.xin16 = (const bf16*)(F.ws + WS_X16); R.xout16 = (bf16*)(F.ws + WS_X16); }
            R.lnpre = (const float*)ap->in[3] + l * D; R.sh = modl; R.sc = modl + D; R.hout = HB;
            R.wfg = (const float*)(F.ws + WS_WFG) + (size_t)l * 6 * D; R.bfg = (const float*)ap->in[10] + l * 6; R.logf = (float*)(F.ws + WS_LOGF);
            phase_rows(F, R); SEAM(p0); }
        if (IN(p0 + 1)) { PHASE_SETUP();
            fgate_scan(F);
            pg8::GSched S; S.init(M / 256, NQKV / 256, D, F.G, F.blk, HB, (const bf16*)(F.ws + WS_WIN) + (size_t)l * NQKV * D, 0);
            pg8::EpiQKV E{BIG, (size_t)M * D, (const float*)(F.ws + WS_ROPE), (float*)(F.ws + WS_CTL + CTL_KM) + (size_t)l * 32768, QSCALE};
            pg8::gemm_phase<pg8::EpiQKV, pg8::GSched, true, true>(F.lds, D, S, E);
            SEAM(p0 + 1); }
        if (IN(p0 + 2)) { PHASE_SETUP();
#if defined(ATTN_NAIVE)
            phase_attn_naive(F, l);
#else
            { int tid_ = F.tid; asm volatile("" : "+v"(tid_));
              att::attn_phase((char*)lds_raw, tid_, F.blk, F.G, BIG, BIG + (size_t)M * D, BIG + (size_t)2 * M * D, HB, (const float*)(F.ws + WS_FB), (const float*)(F.ws + WS_CTL + CTL_KM) + (size_t)l * 32768); }
#endif
            SEAM(p0 + 2); }
        if (IN(p0 + 3)) { PHASE_SETUP();
            pg8::GSched S; S.init(M / 256, D / 256, D, F.G, F.blk, HB, (const bf16*)(F.ws + WS_WOUT) + (size_t)l * D * D, 0);
            pg8::EpiBf16 E{YB, D, 1.0f};
            pg8::gemm_phase<pg8::EpiBf16, pg8::GSched, true, true>(F.lds, D, S, E);
            SEAM(p0 + 3); }
        if (IN(p0 + 4)) { PHASE_SETUP(); const float* modl = mod + (size_t)l * BATCH * NMOD;
            RowArgs R{}; R.has_post = 1; R.moe_y = 0; R.has_pre = 1; R.fg = 0; R.router = l; R.out8 = (l == 0 && (DENSE_F8 & 1)) ? 1 : 0;
            R.xin = l == 0 ? (const float*)ap->in[0] : ap->out; R.xout = ap->out; R.Y = YB; R.gvec = modl + 2 * D; R.lnpost = (const float*)ap->in[4] + l * D;
            if (X_BF16) { R.xout16 = (bf16*)(F.ws + WS_X16); if (l == 1) R.xin16 = (const bf16*)(F.ws + WS_X16); }
            R.lnpre = (const float*)ap->in[5] + l * D; R.sh = modl + 3 * D; R.sc = modl + 4 * D; R.hout = HB;
            R.wrt = (const float*)(F.ws + WS_WRT); R.brt = (const float*)ap->in[16]; R.tope = (int*)(F.ws + WS_TOPE); R.topp_out = (float*)(F.ws + WS_TOPP); R.cnt = (int*)(F.ws + WS_CNT);
            phase_rows(F, R); SEAM(p0 + 4); }
        if (l == 0) {
            if (IN(p0 + 6)) { PHASE_SETUP();
                constexpr int KG = (DENSE_F8 & 1) ? D / 2 : D; constexpr float SG = (DENSE_F8 & 1) ? 1.0f / W8_SCALE_GU : 1.0f;
                pg8::GSched S; S.init(M / 256, 2 * DFF / 256, KG, F.G, F.blk, HB, (const bf16*)(F.ws + WS_WGU), 0);
                if constexpr (DENSE_F8 & 2) { pg8::EpiSwiGLU8 E{(unsigned char*)BIG, DFF, SG}; pg8::gemm_phase<pg8::EpiSwiGLU8, pg8::GSched, true, true, (DENSE_F8 & 1) != 0>(F.lds, KG, S, E); }
                else { pg8::EpiSwiGLU E{BIG, DFF, SG}; pg8::gemm_phase<pg8::EpiSwiGLU, pg8::GSched, true, true, (DENSE_F8 & 1) != 0>(F.lds, KG, S, E); }
                SEAM(p0 + 6); }
            if (IN(p0 + 7)) { PHASE_SETUP();
                constexpr int KD = (DENSE_F8 & 2) ? DFF / 2 : DFF; constexpr float SD = (DENSE_F8 & 2) ? 1.0f / W8_SCALE_D : 1.0f;
                pg8::GSched S; S.init(M / 256, D / 256, KD, F.G, F.blk, BIG, (const bf16*)(F.ws + WS_WD), 0);
                pg8::EpiBf16 E{YB, D, SD};
                pg8::gemm_phase<pg8::EpiBf16, pg8::GSched, true, true, (DENSE_F8 & 2) != 0>(F.lds, KD, S, E);
                SEAM(p0 + 7); }
        } else {
            if (IN(p0 + 5)) { PHASE_SETUP(); phase_scatter(F); SEAM(p0 + 5); }
            if (IN(p0 + 6)) { PHASE_SETUP();
                const int* meta = (const int*)(F.ws + WS_META);
                pg8::GSched S; S.init(meta[8], 2 * DFF / 256, D / 2, F.G, F.blk, AS, (const bf16*)(F.ws + WS_EGU), SZ_EGU8);
                S.ts1 = meta[1]; S.ts2 = meta[2]; S.ts3 = meta[3]; S.ts4 = meta[4]; S.ts5 = meta[5]; S.ts6 = meta[6]; S.ts7 = meta[7];
                pg8::EpiSwiGLU8 E{(unsigned char*)BIG, DFF, 1.0f / W8_SCALE_GU};
                pg8::gemm_phase<pg8::EpiSwiGLU8, pg8::GSched, true, true, true>(F.lds, D / 2, S, E);
                SEAM(p0 + 6); }
            if (IN(p0 + 7)) { PHASE_SETUP();
                const int* meta = (const int*)(F.ws + WS_META);
                const int rs = meta[20], nsp = meta[21];
                { pg8::GSched S; S.init(meta[8] - rs, D / 256, DFF / 2, F.G, F.blk, BIG, (const bf16*)(F.ws + WS_ED), SZ_ED8);
                  S.ts1 = meta[1]; S.ts2 = meta[2]; S.ts3 = meta[3]; S.ts4 = meta[4]; S.ts5 = meta[5]; S.ts6 = meta[6]; S.ts7 = meta[7];
                  pg8::EpiBf16 E{YS, D, 1.0f / W8_SCALE_D};
                  pg8::gemm_phase<pg8::EpiBf16, pg8::GSched, true, true, true>(F.lds, DFF / 2, S, E); }
                if (rs > 0) {
                  pg8::GSchedK S; S.init(rs, (D / 256) * nsp, DFF / 2, F.G, F.blk, BIG, (const bf16*)(F.ws + WS_ED), SZ_ED8);
                  S.ts1 = meta[1]; S.ts2 = meta[2]; S.ts3 = meta[3]; S.ts4 = meta[4]; S.ts5 = meta[5]; S.ts6 = meta[6]; S.ts7 = meta[7]; S.pm0 = meta[8] - rs; S.kbytes = (size_t)(DFF / nsp);
                  pg8::EpiBf16K E{(bf16*)(F.ws + WS_PART), D, 1.0f / W8_SCALE_D, PART_STRIDE};
                  pg8::gemm_phase<pg8::EpiBf16K, pg8::GSchedK, true, true, true>(F.lds, DFF / 2, S, E, (DFF / 128) / nsp); }
                SEAM(p0 + 7); }
        }
    }
__global__ void __launch_bounds__(NTHREADS, 2) fwd_kernel(Args args) {
    extern __shared__ __attribute__((aligned(16))) unsigned char lds_raw[];
    volatile LAS unsigned* MISC = (volatile LAS unsigned*)((LAS unsigned char*)lds_raw + MISC_OFF);
    if (threadIdx.x < 64) MISC[threadIdx.x] = 0u;
    __syncthreads();
    if (MK_N_LAUNCHES == 1) (void)xcd_barrier_post((unsigned*)(args.ws + WS_CTL) + CW_BAR, MISC);
    const int lo = args.ph_lo, hi = args.ph_hi;
    if (IN(0)) { PHASE_SETUP(); phase_prologue_a(F, ap); SEAM(0); }
    if (IN(1)) { PHASE_SETUP(); phase_prologue_b(F, ap); SEAM(1); }

    layer_phases<0>(lds_raw, lo, hi);
    layer_phases<1>(lds_raw, lo, hi);
    if (IN(18)) { PHASE_SETUP();
        RowArgs R{}; R.has_post = 1; R.moe_y = 1; R.has_pre = 0; R.fg = 0; R.router = 0;
        R.xin = ap->out; R.xout = ap->out; R.Y = AS; R.slot = (const int*)(F.ws + WS_SLOT); R.topp = (const float*)(F.ws + WS_TOPP);
        if (X_BF16) R.xin16 = (const bf16*)(F.ws + WS_X16);
        { const int* meta = (const int*)(F.ws + WS_META); R.part = (const bf16*)(F.ws + WS_PART); R.split_base = meta[22]; R.nsplit = meta[21]; }
        R.gvec = mod + (size_t)BATCH * NMOD + 5 * D; R.lnpost = (const float*)ap->in[6] + D;
        phase_rows(F, R); }
#undef IN
#undef SEAM
#undef PHASE_SETUP
}

extern "C" void kernel_launch(void* const* d_in, const int* in_sizes, int n_in, void* d_out, int out_size, void* d_ws, size_t ws_size, hipStream_t stream) {
    static int grid = 0;
    if (grid == 0) {
        if (n_in != 20 || in_sizes[0] != M * D || out_size != M * D || ws_size < WS_END) { fprintf(stderr, "kernel_launch: shape/workspace mismatch (n_in %d, in0 %d, out %d, ws %zu, need %zu)\n", n_in, n_in > 0 ? in_sizes[0] : -1, out_size, ws_size, (size_t)WS_END); grid = -1; return; }
        int dev = 0, cus = 0, per_cu = 0;
        if (hipGetDevice(&dev) != hipSuccess || hipDeviceGetAttribute(&cus, hipDeviceAttributeMultiprocessorCount, dev) != hipSuccess) { grid = -1; return; }
        if (hipFuncSetAttribute((const void*)fwd_kernel, hipFuncAttributeMaxDynamicSharedMemorySize, LDS_BYTES) != hipSuccess) { fprintf(stderr, "kernel_launch: hipFuncSetAttribute failed\n"); grid = -1; return; }
        if (hipOccupancyMaxActiveBlocksPerMultiprocessor(&per_cu, (const void*)fwd_kernel, NTHREADS, LDS_BYTES) != hipSuccess || per_cu < 1) fprintf(stderr, "kernel_launch: occupancy query says %d\n", per_cu);
        (void)hipGetLastError();
        if (cus != 256) { fprintf(stderr, "kernel_launch: built for 256 CUs, device has %d\n", cus); grid = -1; return; }
        grid = cus;
    }
    if (grid < 0) return;
    if (hipMemsetAsync((char*)d_ws + WS_CTL, 0, CTL_ZERO_BYTES, stream) != hipSuccess) return;
    Args a{};
    for (int i = 0; i < 20; ++i) a.in[i] = d_in[i];
    a.out = (float*)d_out; a.ws = (unsigned char*)d_ws;
    if (MK_N_LAUNCHES == 1) { a.ph_lo = 0; a.ph_hi = NPHASES; hipLaunchKernelGGL(fwd_kernel, dim3(grid), dim3(NTHREADS), LDS_BYTES, stream, a); }
    else { for (int p = 0; p < NPHASES; ++p) { if (p == 7) continue; a.ph_lo = p; a.ph_hi = p + 1; hipLaunchKernelGGL(fwd_kernel, dim3(grid), dim3(NTHREADS), LDS_BYTES, stream, a); } }
}
```
